# Optimizing an MI355X kernel written in HIP

```python
import jax, jax.numpy as jnp
from jax import lax
import numpy as np

D_MODEL = 1024
BATCH = 2
SEQ = 8192
DEPTH = 2

CHUNK = 64
Q_BLOCK = 128
NORM_EPS = 1e-6

GDN_HEADS = 4
GDN_HEAD_DIM = 128
GDN_WIDTH = GDN_HEADS * GDN_HEAD_DIM
CONV_WIDTH = 4

MLA_HEADS = 8
MLA_NOPE_DIM = 64
MLA_ROPE_DIM = 32
MLA_V_DIM = 64
MLA_Q_RANK = 256
MLA_KV_RANK = 128
MLA_WIDTH = MLA_HEADS * MLA_V_DIM
ROPE_THETA = 10000.0

MIX_WIDTH = GDN_WIDTH + MLA_WIDTH
D_FF = 4 * D_MODEL

IN_SIZES = (GDN_WIDTH, GDN_WIDTH, GDN_WIDTH, GDN_WIDTH, GDN_HEADS, GDN_HEADS,
            MLA_Q_RANK, MLA_KV_RANK, MLA_ROPE_DIM)
IN_WIDTH = 4 * GDN_WIDTH + 2 * GDN_HEADS + MLA_Q_RANK + MLA_KV_RANK + MLA_ROPE_DIM

kernel_name = "hybrid_gdn_mla_sandwich_block"


def rms_norm(x, gain):
    xf = x.astype(jnp.float32)
    y = xf * lax.rsqrt(jnp.mean(xf * xf, axis=-1, keepdims=True) + NORM_EPS)
    return (y * gain.astype(jnp.float32)).astype(x.dtype)


def l2_norm(x):
    xf = x.astype(jnp.float32)
    return xf * lax.rsqrt(jnp.sum(xf * xf, axis=-1, keepdims=True) + NORM_EPS)


def causal_depthwise_conv(x, w):
    k = w.shape[0]
    return lax.conv_general_dilated(
        x, w[:, None, :].astype(x.dtype), window_strides=(1,), padding=[(k - 1, 0)],
        dimension_numbers=("NWC", "WIO", "NWC"), feature_group_count=x.shape[-1])


def rope_angles(positions):
    inv_freq = ROPE_THETA ** (-jnp.arange(0, MLA_ROPE_DIM, 2, dtype=jnp.float32) / MLA_ROPE_DIM)
    ang = positions.astype(jnp.float32)[..., None] * inv_freq
    return jnp.cos(ang), jnp.sin(ang)


def apply_rope(x, cos, sin):
    xf = x.astype(jnp.float32)
    x1, x2 = jnp.split(xf, 2, axis=-1)
    return jnp.concatenate([x1 * cos - x2 * sin, x2 * cos + x1 * sin], axis=-1).astype(x.dtype)


def gated_delta_rule(q, k, v, beta, log_a):
    b, s, h, dk = q.shape
    dv = v.shape[-1]
    n = s // CHUNK

    def chunks(t):
        t = t.reshape((b, n, CHUNK, h) + t.shape[3:])
        return jnp.moveaxis(t, 3, 1)

    q, k, v = chunks(q), chunks(k), chunks(v)
    beta, log_a = chunks(beta), chunks(log_a)
    g = jnp.cumsum(log_a, axis=-1)
    idx = jnp.arange(CHUNK)
    strict = idx[:, None] > idx[None, :]
    causal = idx[:, None] >= idx[None, :]
    gdiff = g[..., :, None] - g[..., None, :]
    decay_strict = jnp.exp(jnp.where(strict, gdiff, -jnp.inf))
    decay_causal = jnp.exp(jnp.where(causal, gdiff, -jnp.inf))

    k_beta = k * beta[..., None]
    a_mat = jnp.einsum("bhnid,bhnjd->bhnij", k_beta, k) * decay_strict
    eye = jnp.eye(CHUNK, dtype=jnp.float32)
    t_inv = lax.linalg.triangular_solve(eye + a_mat, jnp.broadcast_to(eye, a_mat.shape),
                                        left_side=True, lower=True)
    u = t_inv @ (v * beta[..., None])
    w = t_inv @ (k_beta * jnp.exp(g)[..., None])
    p = jnp.einsum("bhnid,bhnjd->bhnij", q, k) * decay_causal
    q_dec = q * jnp.exp(g)[..., None]
    g_last = g[..., -1]
    k_dec = k * jnp.exp(g_last[..., None] - g)[..., None]

    def step(state, xs):
        q_c, k_c, u_c, w_c, p_c, gl = xs
        v_new = u_c - jnp.einsum("bhcd,bhde->bhce", w_c, state)
        o = (jnp.einsum("bhcd,bhde->bhce", q_c, state)
             + jnp.einsum("bhij,bhje->bhie", p_c, v_new))
        state = state * jnp.exp(gl)[..., None, None] + jnp.einsum("bhcd,bhce->bhde", k_c, v_new)
        return state, o

    xs = tuple(jnp.moveaxis(t, 2, 0) for t in (q_dec, k_dec, u, w, p, g_last))
    state0 = jnp.zeros((b, h, dk, dv), jnp.float32)
    _, o = lax.scan(step, state0, xs)
    return jnp.transpose(o, (1, 0, 3, 2, 4)).reshape(b, s, h, dv)


def gated_deltanet_group(q, k, v, gate, a_logit, b_logit, conv_w, a_log, dt_bias, out_norm):
    bsz, s, _ = q.shape
    qkv = jax.nn.silu(causal_depthwise_conv(jnp.concatenate([q, k, v], axis=-1), conv_w))
    q, k, v = jnp.split(qkv, 3, axis=-1)
    q = l2_norm(q.reshape(bsz, s, GDN_HEADS, GDN_HEAD_DIM)) * (GDN_HEAD_DIM ** -0.5)
    k = l2_norm(k.reshape(bsz, s, GDN_HEADS, GDN_HEAD_DIM))
    v = v.reshape(bsz, s, GDN_HEADS, GDN_HEAD_DIM).astype(jnp.float32)
    beta = jax.nn.sigmoid(b_logit.astype(jnp.float32))
    log_a = -jnp.exp(a_log.astype(jnp.float32)) * jax.nn.softplus(
        a_logit.astype(jnp.float32) + dt_bias.astype(jnp.float32))
    o = gated_delta_rule(q, k, v, beta, log_a)
    g = jax.nn.silu(gate.astype(jnp.float32)).reshape(bsz, s, GDN_HEADS, GDN_HEAD_DIM)
    o = rms_norm(o, out_norm) * g
    return o.reshape(bsz, s, GDN_WIDTH).astype(gate.dtype)


def mla_group(c_q, c_kv, k_rope, cos, sin, q_norm, w_q_up, kv_norm, w_kv_up):
    b, s, _ = c_q.shape
    dqk = MLA_NOPE_DIM + MLA_ROPE_DIM
    q = (rms_norm(c_q, q_norm) @ w_q_up).reshape(b, s, MLA_HEADS, dqk)
    q_nope, q_rope = q[..., :MLA_NOPE_DIM], q[..., MLA_NOPE_DIM:]
    kv = (rms_norm(c_kv, kv_norm) @ w_kv_up).reshape(b, s, MLA_HEADS, MLA_NOPE_DIM + MLA_V_DIM)
    k_nope, v = kv[..., :MLA_NOPE_DIM], kv[..., MLA_NOPE_DIM:]
    q_rope = apply_rope(q_rope, cos[:, :, None, :], sin[:, :, None, :])
    k_rope = apply_rope(k_rope, cos, sin)
    q = jnp.concatenate([q_nope, q_rope], axis=-1)
    k = jnp.concatenate(
        [k_nope, jnp.broadcast_to(k_rope[:, :, None, :], (b, s, MLA_HEADS, MLA_ROPE_DIM))], axis=-1)
    scale = dqk ** -0.5
    n_blk = s // Q_BLOCK
    q_blocks = jnp.moveaxis(q.reshape(b, n_blk, Q_BLOCK, MLA_HEADS, dqk), 1, 0)
    key_chunk = jnp.arange(s) // CHUNK

    def attend(xs):
        q_b, blk = xs
        q_chunk = (blk * Q_BLOCK + jnp.arange(Q_BLOCK)) // CHUNK
        scores = jnp.einsum("bqhd,bkhd->bhqk", q_b, k,
                            preferred_element_type=jnp.float32) * scale
        mask = key_chunk[None, :] <= q_chunk[:, None]
        probs = jax.nn.softmax(jnp.where(mask, scores, -jnp.inf), axis=-1).astype(v.dtype)
        return jnp.einsum("bhqk,bkhd->bqhd", probs, v)

    o = lax.map(attend, (q_blocks, jnp.arange(n_blk)))
    return jnp.moveaxis(o, 0, 1).reshape(b, s, MLA_WIDTH)


def setup_inputs(seed: int = 0) -> dict:
    key = jax.random.key(seed)
    ks = jax.random.split(key, 20)
    f32 = jnp.float32

    def normal(k, shape, fan_in):
        return jax.random.normal(k, shape, f32) * (fan_in ** -0.5)

    def gain(k, shape):
        return 1.0 + 0.1 * jax.random.normal(k, shape, f32)

    x = jax.random.normal(ks[0], (BATCH, SEQ, D_MODEL), f32)
    offsets = jax.random.randint(ks[1], (BATCH, 1), 0, 4096)
    positions = (offsets + jnp.arange(SEQ)[None, :]).astype(jnp.int32)
    a_log = jnp.log(jax.random.uniform(ks[2], (DEPTH, GDN_HEADS), f32, 1.0, 16.0))
    dt = jnp.exp(jax.random.uniform(ks[3], (DEPTH, GDN_HEADS), f32,
                                    float(np.log(1e-3)), float(np.log(1e-1))))
    dt_bias = dt + jnp.log(-jnp.expm1(-dt))
    return {
        "x": x,
        "positions": positions,
        "mix_pre_norm": gain(ks[4], (DEPTH, D_MODEL)),
        "w_in": normal(ks[5], (DEPTH, D_MODEL, IN_WIDTH), D_MODEL),
        "conv_w": normal(ks[6], (DEPTH, CONV_WIDTH, 3 * GDN_WIDTH), CONV_WIDTH),
        "a_log": a_log,
        "dt_bias": dt_bias,
        "gdn_out_norm": gain(ks[7], (DEPTH, GDN_HEAD_DIM)),
        "q_norm": gain(ks[8], (DEPTH, MLA_Q_RANK)),
        "w_q_up": normal(ks[9], (DEPTH, MLA_Q_RANK, MLA_HEADS * (MLA_NOPE_DIM + MLA_ROPE_DIM)), MLA_Q_RANK),
        "kv_norm": gain(ks[10], (DEPTH, MLA_KV_RANK)),
        "w_kv_up": normal(ks[11], (DEPTH, MLA_KV_RANK, MLA_HEADS * (MLA_NOPE_DIM + MLA_V_DIM)), MLA_KV_RANK),
        "w_out": normal(ks[12], (DEPTH, MIX_WIDTH, D_MODEL), MIX_WIDTH),
        "mix_post_norm": gain(ks[13], (DEPTH, D_MODEL)),
        "ffn_pre_norm": gain(ks[14], (DEPTH, D_MODEL)),
        "w_up": normal(ks[15], (DEPTH, D_MODEL, D_FF), D_MODEL),
        "w_down": normal(ks[16], (DEPTH, D_FF, D_MODEL), D_FF),
        "ffn_post_norm": gain(ks[17], (DEPTH, D_MODEL)),
    }


def reference(x, positions, mix_pre_norm, w_in, conv_w, a_log, dt_bias, gdn_out_norm,
              q_norm, w_q_up, kv_norm, w_kv_up, w_out, mix_post_norm,
              ffn_pre_norm, w_up, w_down, ffn_post_norm):
    cos, sin = rope_angles(positions)
    offsets = [int(o) for o in np.cumsum(IN_SIZES)[:-1]]
    for l in range(DEPTH):
        h = rms_norm(x, mix_pre_norm[l])
        proj = h @ w_in[l]
        gq, gk, gv, gg, ga, gb, cq, ckv, kr = jnp.split(proj, offsets, axis=-1)
        o_gdn = gated_deltanet_group(gq, gk, gv, gg, ga, gb, conv_w[l], a_log[l],
                                     dt_bias[l], gdn_out_norm[l])
        o_mla = mla_group(cq, ckv, kr, cos, sin, q_norm[l], w_q_up[l], kv_norm[l], w_kv_up[l])
        mixed = jnp.concatenate([o_gdn.astype(x.dtype), o_mla.astype(x.dtype)], axis=-1) @ w_out[l]
        x = x + rms_norm(mixed, mix_post_norm[l])
        h = rms_norm(x, ffn_pre_norm[l])
        f = jnp.square(jax.nn.relu(h @ w_up[l])) @ w_down[l]
        x = x + rms_norm(f, ffn_post_norm[l])
    return x
```

```cpp
#include <hip/hip_runtime.h>
#include <cstdio>
#include <cstdint>
namespace pg8 {
#define PG8_LAS __attribute__((address_space(3)))
typedef unsigned short bf16_t;
typedef short bf16x8 __attribute__((ext_vector_type(8)));
typedef float f32x4 __attribute__((ext_vector_type(4)));
typedef unsigned u32x4 __attribute__((ext_vector_type(4)));
constexpr int BM = 256, BK = 64, HALF = 128, HTB = HALF * BK * 2  , STAGE_BYTES = 8 * HTB, NXCD = 8, WGM = 8;

__host__ __device__ __forceinline__ int lds_byte(int r, int c) { const int st = (r >> 4) * 2 + (c >> 5), rr = r & 15, cc = c & 31, ob = rr * 64 + cc * 2; return st * 1024 + (ob ^ (((ob >> 9) & 1) << 5)); }
__host__ __device__ __forceinline__ void stage_rc(int b, int& R, int& C) { const int st = b / 1024, sb = b % 1024, swz = sb ^ (((sb >> 9) & 1) << 5); R = (st >> 1) * 16 + swz / 64; C = (st & 1) * 32 + (swz % 64) / 2; }
__host__ __device__ __forceinline__ int perm32(int rho) { const int n = rho >> 4, i = rho & 15; return 8 * (i >> 2) + 4 * n + (i & 3); }

struct Unit { int pm, pn; };
struct Gemm { const bf16_t* A; const bf16_t* Bt; int M, N, K; };

struct StaticOrder {
    int nM, nN, nwg, G, c;
    __host__ __device__ __forceinline__ void init(int M, int N, int G_, int c_) { nM = M / BM; nN = N / BM; nwg = nM * nN; G = G_; c = c_; }
    __host__ __device__ __forceinline__ bool next(int i, Unit& u) const {
        const long L = (long)i * G + c; if (L >= nwg) return false;
        int wgid = (int)L; { const int q = nwg / NXCD, r = nwg % NXCD, xcd = wgid % NXCD, off = wgid / NXCD; wgid = (xcd < r ? xcd * (q + 1) : r * (q + 1) + (xcd - r) * q) + off; }
        const int nig = WGM * nN, gid = wgid / nig, fm = gid * WGM, gsz = (nM - fm) < WGM ? (nM - fm) : WGM;
        u.pm = fm + ((wgid % nig) % gsz); u.pn = (wgid % nig) / gsz; return true;
    }
    __device__ __forceinline__ void a_ready(const Unit&) const {}
    __device__ __forceinline__ void done(const Unit&) const {}
};

__device__ __forceinline__ float shx(float v, int lane, int o) { return __builtin_bit_cast(float, __builtin_amdgcn_ds_bpermute((lane ^ o) << 2, __builtin_bit_cast(int, v))); }
__device__ __forceinline__ unsigned cvt_pk_bf16(float lo, float hi) { unsigned r; asm volatile("v_cvt_pk_bf16_f32 %0, %1, %2" : "=v"(r) : "v"(lo), "v"(hi)); return r; }

template <int mode, int act, bool HAS_SCALE> struct EpiPk {
    static constexpr bool PERM = true, AFTER_DRAIN = false;
    bf16_t *p0, *p1, *p2, *p3, *p4; int ldc; const float* rowscale;
    __device__ __forceinline__ bf16_t* dst(int row, int col) const {
        if (mode == 0) return p0 + (size_t)row * ldc + col;
        if (mode == 1) { const int pt = col >> 9; bf16_t* b = pt == 0 ? p0 : pt == 1 ? p1 : pt == 2 ? p2 : pt == 3 ? p3 : p4; return b + (size_t)row * 512 + (col & 511); }
        const int h = col >> 7, d = col & 127;
        return d < 64 ? p0 + (size_t)row * 768 + h * 96 + d : p1 + (size_t)row * 512 + h * 64 + (d - 64);
    }
    __device__ __forceinline__ void operator()(const f32x4 (&acc)[2][2][4][2], const Unit& u, int wr, int wc, int fr, int fq) const {
        const int row0 = u.pm * BM + wr * 64 + fr, col0 = u.pn * BM + wc * 32 + 8 * fq;
#pragma unroll
        for (int ai = 0; ai < 2; ++ai)
#pragma unroll
            for (int m = 0; m < 4; ++m) { const int row = row0 + ai * HALF + m * 16; const float sc = HAS_SCALE ? rowscale[row] : 1.f;
#pragma unroll
                for (int bj = 0; bj < 2; ++bj) { f32x4 v0 = acc[ai][bj][m][0], v1 = acc[ai][bj][m][1];
                    if (act == 2) {
#pragma unroll
                        for (int e = 0; e < 4; ++e) { v0[e] = v0[e] > 0.f ? v0[e] * v0[e] : 0.f; v1[e] = v1[e] > 0.f ? v1[e] * v1[e] : 0.f; } }
                    if (mode == 1 && ((col0 + bj * HALF) >> 9) == 3) {
#pragma unroll
                        for (int e = 0; e < 4; ++e) { v0[e] = v0[e] * __builtin_amdgcn_rcpf(1.f + __expf(-v0[e])); v1[e] = v1[e] * __builtin_amdgcn_rcpf(1.f + __expf(-v1[e])); } }
                    v0 = v0 * sc; v1 = v1 * sc; u32x4 w; w.x = cvt_pk_bf16(v0[0], v0[1]); w.y = cvt_pk_bf16(v0[2], v0[3]); w.z = cvt_pk_bf16(v1[0], v1[1]); w.w = cvt_pk_bf16(v1[2], v1[3]);
                    *(u32x4*)dst(row, col0 + bj * HALF) = w; } }
    }
};
struct EpiF32 {
    static constexpr bool PERM = false, AFTER_DRAIN = false;
    float* O; int ldc;
    __device__ __forceinline__ void operator()(const f32x4 (&acc)[2][2][4][2], const Unit& u, int wr, int wc, int fr, int fq) const {
        const int row0 = u.pm * BM + wr * 64 + fr, col0 = u.pn * BM + wc * 32 + 4 * fq;
#pragma unroll
        for (int ai = 0; ai < 2; ++ai)
#pragma unroll
            for (int m = 0; m < 4; ++m) { float* rowp = O + (size_t)(row0 + ai * HALF + m * 16) * ldc + col0;
#pragma unroll
                for (int bj = 0; bj < 2; ++bj)
#pragma unroll
                    for (int n = 0; n < 2; ++n) *(f32x4*)(rowp + bj * HALF + n * 16) = acc[ai][bj][m][n]; }
    }
};

struct PanelRms {
    float* xbuf;
    unsigned* cnt;
    unsigned* tmo;
    float eps;
    __device__ __forceinline__ void run(const f32x4 (&v)[2][2][4][2], const Unit& u, int wr, int wc, int fr, int fq, PG8_LAS unsigned char* lds, int wid, int lane) const {
        PG8_LAS float* P = (PG8_LAS float*)lds;
        PG8_LAS float* S = (PG8_LAS float*)(lds + 8192);
#pragma unroll
        for (int ai = 0; ai < 2; ++ai)
#pragma unroll
            for (int m = 0; m < 4; ++m) {
                float q = 0.f;
#pragma unroll
                for (int bj = 0; bj < 2; ++bj)
#pragma unroll
                    for (int n = 0; n < 2; ++n) { const f32x4 d = v[ai][bj][m][n]; q += (d[0] * d[0] + d[1] * d[1]) + (d[2] * d[2] + d[3] * d[3]); }
                q += shx(q, lane, 16); q += shx(q, lane, 32);
                if (fq == 0) P[(ai * HALF + wr * 64 + m * 16 + fr) * 4 + wc] = q;
            }
        asm volatile("s_waitcnt lgkmcnt(0)" ::: "memory"); __builtin_amdgcn_s_barrier(); asm volatile("" ::: "memory");
        const int row = wid * 32 + (lane & 31);
        if (lane < 32) {
            const float t = (P[row * 4 + 0] + P[row * 4 + 1]) + (P[row * 4 + 2] + P[row * 4 + 3]);
            __hip_atomic_store(xbuf + ((size_t)(u.pm * BM + row) * 4 + u.pn), t, __ATOMIC_RELAXED, __HIP_MEMORY_SCOPE_AGENT);
        }
        asm volatile("s_waitcnt vmcnt(0)" ::: "memory");
        if (lane == 0) __hip_atomic_fetch_add(cnt + 64 * u.pm, 1u, __ATOMIC_RELAXED, __HIP_MEMORY_SCOPE_AGENT);
        if (wid == 0) {
            while ((unsigned)__builtin_amdgcn_readfirstlane(__hip_atomic_load(cnt + 64 * u.pm, __ATOMIC_RELAXED, __HIP_MEMORY_SCOPE_AGENT)) < 32u) __builtin_amdgcn_s_sleep(2);
            __builtin_amdgcn_fence(__ATOMIC_ACQUIRE, "agent");
        }
        asm volatile("s_waitcnt vmcnt(0) lgkmcnt(0)" ::: "memory"); __builtin_amdgcn_s_barrier(); asm volatile("" ::: "memory");
        if (lane < 32) {
            const float* slot = xbuf + (size_t)(u.pm * BM + row) * 4; float tot = 0.f;
#pragma unroll
            for (int t = 0; t < 4; ++t) tot += __hip_atomic_load(slot + t, __ATOMIC_RELAXED, __HIP_MEMORY_SCOPE_AGENT);
            S[row] = 1.0f / sqrtf(tot * (1.0f / 1024.0f) + eps);
        }
        asm volatile("s_waitcnt lgkmcnt(0)" ::: "memory"); __builtin_amdgcn_s_barrier(); asm volatile("" ::: "memory");
    }
};
struct EpiRmsResRms {
    static constexpr bool PERM = false, AFTER_DRAIN = true;
    const void* base; void* out; bf16_t* xn; const float* g1; const float* g2; PanelRms st1, st2; int base_bf, out_bf;
    __device__ __forceinline__ void fused(f32x4 (&acc)[2][2][4][2], const Unit& u, int wr, int wc, int fr, int fq, PG8_LAS unsigned char* lds, int wid, int lane) const {
        typedef unsigned u32x2v __attribute__((ext_vector_type(2)));
        const PG8_LAS float* S = (const PG8_LAS float*)(lds + 8192);
        const int col0 = u.pn * BM + wc * 32 + 4 * fq;
        st1.run(acc, u, wr, wc, fr, fq, lds, wid, lane);
#pragma unroll
        for (int ai = 0; ai < 2; ++ai)
#pragma unroll
            for (int m = 0; m < 4; ++m) { const int r = ai * HALF + wr * 64 + m * 16 + fr; const float sr = S[r]; const size_t off = (size_t)(u.pm * BM + r) * 1024 + col0;
                f32x4 bs[2][2];
                if (base_bf) {
#pragma unroll
                    for (int bj = 0; bj < 2; ++bj)
#pragma unroll
                        for (int n = 0; n < 2; ++n) { const u32x2v w = *(const u32x2v*)((const bf16_t*)base + off + bj * HALF + n * 16);
                            bs[bj][n] = (f32x4){__builtin_bit_cast(float, w.x << 16), __builtin_bit_cast(float, w.x & 0xffff0000u), __builtin_bit_cast(float, w.y << 16), __builtin_bit_cast(float, w.y & 0xffff0000u)}; }
                } else {
#pragma unroll
                    for (int bj = 0; bj < 2; ++bj)
#pragma unroll
                        for (int n = 0; n < 2; ++n) bs[bj][n] = *(const f32x4*)((const float*)base + off + bj * HALF + n * 16);
                }
#pragma unroll
                for (int bj = 0; bj < 2; ++bj)
#pragma unroll
                    for (int n = 0; n < 2; ++n) { const f32x4 gv = *(const f32x4*)(g1 + col0 + bj * HALF + n * 16); acc[ai][bj][m][n] = bs[bj][n] + acc[ai][bj][m][n] * sr * gv; }
                asm volatile("" : "+v"(acc[ai][0][m][0]), "+v"(acc[ai][0][m][1]), "+v"(acc[ai][1][m][0]), "+v"(acc[ai][1][m][1]));
                if (m & 1) asm volatile("" ::: "memory"); }
        if (xn) st2.run(acc, u, wr, wc, fr, fq, lds, wid, lane);
#pragma unroll
        for (int ai = 0; ai < 2; ++ai)
#pragma unroll
            for (int m = 0; m < 4; ++m) { const int r = ai * HALF + wr * 64 + m * 16 + fr; const float sr = S[r]; const size_t off = (size_t)(u.pm * BM + r) * 1024 + col0;
#pragma unroll
                for (int bj = 0; bj < 2; ++bj)
#pragma unroll
                    for (int n = 0; n < 2; ++n) { const f32x4 x1 = acc[ai][bj][m][n]; if (out_bf) { u32x2v w; w.x = cvt_pk_bf16(x1[0], x1[1]); w.y = cvt_pk_bf16(x1[2], x1[3]); *(u32x2v*)((bf16_t*)out + off + bj * HALF + n * 16) = w; } else *(f32x4*)((float*)out + off + bj * HALF + n * 16) = x1;
                        if (xn) { const f32x4 gv = *(const f32x4*)(g2 + col0 + bj * HALF + n * 16); const f32x4 o = x1 * sr * gv; u32x2v w; w.x = cvt_pk_bf16(o[0], o[1]); w.y = cvt_pk_bf16(o[2], o[3]); *(u32x2v*)(xn + off + bj * HALF + n * 16) = w; } }
                asm volatile("" ::: "memory"); }
    }
};

template <class Epi, class Sched, bool ALIGN_EPI = false>
__device__ __forceinline__ void gemm_phase(PG8_LAS unsigned char* lds, const Gemm g, const Sched& S, const Epi& E, int tid_in) {
    int tid_ = tid_in; asm volatile("" : "+v"(tid_));
    const int tid = tid_, wid = __builtin_amdgcn_readfirstlane(tid >> 6), lane = tid & 63, wr = wid >> 2, wc = wid & 3, fr = lane & 15, fq = lane >> 4;
    int K_ = g.K; asm volatile("" : "+s"(K_));
    const int K = K_, nt = K / BK;
    unsigned voffA[2], voffB[2];
#pragma unroll
    for (int i = 0; i < 2; ++i) { int R, C; stage_rc(tid * 16 + i * 8192, R, C); const int Rb = Epi::PERM ? ((R & ~31) + perm32(R & 31)) : R;
        voffA[i] = (unsigned)(R * K + C) * 2u; voffB[i] = (unsigned)(Rb * K + C) * 2u; }
    const size_t kstep = (size_t)(BK * 2);
    const size_t hstep = (size_t)HALF * K * 2;
    const size_t tstep = 2 * hstep;
    const unsigned ldsw = (unsigned)wid * 1024u;
    const int aoff = lds_byte(wr * 64 + fr, fq * 8), boff = lds_byte(wc * 32 + fr, fq * 8);
#define PG8_SA(b, h) (((b) * 2 + (h)) * HTB)
#define PG8_SB(b, h) ((4 + (b) * 2 + (h)) * HTB)
#define PG8_STAGE(bufoff, gbase, voff) do { _Pragma("unroll") for (int _i = 0; _i < 2; ++_i) \
        __builtin_amdgcn_global_load_lds((const unsigned*)((const char*)(gbase) + (voff)[_i]), (PG8_LAS unsigned*)(lds + (bufoff) + ldsw + _i * 8192), 16, 0, 0); } while (0)
#define PG8_LDA(dst, b, h) do { _Pragma("unroll") for (int m = 0; m < 4; ++m) _Pragma("unroll") for (int k = 0; k < 2; ++k) dst[m][k] = *(const PG8_LAS bf16x8*)(lds + PG8_SA(b, h) + aoff + m * 2048 + k * 1024); } while (0)
#define PG8_LDB(dst, b, h) do { _Pragma("unroll") for (int n = 0; n < 2; ++n) _Pragma("unroll") for (int k = 0; k < 2; ++k) dst[n][k] = *(const PG8_LAS bf16x8*)(lds + PG8_SB(b, h) + boff + n * 2048 + k * 1024); } while (0)
#define PG8_MMA(ai, bj, At, Bt) do { __builtin_amdgcn_s_setprio(1); _Pragma("unroll") for (int m = 0; m < 4; ++m) _Pragma("unroll") for (int n = 0; n < 2; ++n) _Pragma("unroll") for (int k = 0; k < 2; ++k) \
        acc[ai][bj][m][n] = __builtin_amdgcn_mfma_f32_16x16x32_bf16(Bt[n][k], At[m][k], acc[ai][bj][m][n], 0, 0, 0); __builtin_amdgcn_s_setprio(0); } while (0)
#define PG8_WAIT_V(n) asm volatile("s_waitcnt vmcnt(" #n ")" ::: "memory")
#define PG8_WAIT_L(n) asm volatile("s_waitcnt lgkmcnt(" #n ")" ::: "memory")
#define PG8_BAR __builtin_amdgcn_s_barrier()
#define PG8_SCHED __builtin_amdgcn_sched_barrier(0)
    Unit cur, nxt; int ui = 0;
    if (!S.next(0, cur)) return;
    f32x4 acc[2][2][4][2];
#pragma unroll
    for (int a = 0; a < 2; ++a)
#pragma unroll
        for (int b = 0; b < 2; ++b)
#pragma unroll
            for (int m = 0; m < 4; ++m)
#pragma unroll
                for (int n = 0; n < 2; ++n) acc[a][b][m][n] = (f32x4){0.f, 0.f, 0.f, 0.f};
    bf16x8 At[4][2], B0[2][2], B1[2][2];
    const char* cA = (const char*)g.A + (size_t)cur.pm * tstep; const char* cB = (const char*)g.Bt + (size_t)cur.pn * tstep;
    S.a_ready(cur);
    PG8_STAGE(PG8_SB(0, 0), cB, voffB); PG8_STAGE(PG8_SB(0, 1), cB + hstep, voffB); PG8_STAGE(PG8_SA(0, 0), cA, voffA); PG8_STAGE(PG8_SA(0, 1), cA + hstep, voffA);
    if (wr == 1) PG8_BAR;
    PG8_WAIT_V(2); PG8_BAR;
    PG8_STAGE(PG8_SB(1, 0), cB + kstep, voffB); PG8_STAGE(PG8_SA(1, 0), cA + kstep, voffA); PG8_STAGE(PG8_SB(1, 1), cB + hstep + kstep, voffB);
    PG8_WAIT_V(6); PG8_BAR;
    for (;;) {
        const bool has_next = S.next(ui + 1, nxt);
        const char* nA = has_next ? (const char*)g.A + (size_t)nxt.pm * tstep : cA; const char* nB = has_next ? (const char*)g.Bt + (size_t)nxt.pn * tstep : cB;
        for (int t = 0; t < nt; t += 2) {
            const bool last = (t == nt - 2);
            const char* a1 = cA + (size_t)(t + 1) * kstep;
            const char* a2 = last ? nA : cA + (size_t)(t + 2) * kstep; const char* b2 = last ? nB : cB + (size_t)(t + 2) * kstep;
            const char* a3 = a2 + kstep; const char* b3 = b2 + kstep;
            if (last && has_next) S.a_ready(nxt);
            PG8_LDB(B0, 0, 0); PG8_LDB(B1, 0, 1); PG8_SCHED; PG8_LDA(At, 0, 0); PG8_STAGE(PG8_SA(1, 1), a1 + hstep, voffA);
            PG8_WAIT_V(8); PG8_WAIT_L(0); PG8_BAR; PG8_MMA(0, 0, At, B0); PG8_MMA(0, 1, At, B1); PG8_BAR; PG8_SCHED;
            PG8_LDA(At, 0, 1); PG8_STAGE(PG8_SB(0, 0), b2, voffB); PG8_STAGE(PG8_SB(0, 1), b2 + hstep, voffB); PG8_STAGE(PG8_SA(0, 0), a2, voffA);
            PG8_WAIT_V(8); PG8_WAIT_L(0); PG8_BAR; PG8_MMA(1, 0, At, B0); PG8_MMA(1, 1, At, B1); PG8_BAR; PG8_SCHED;
            PG8_LDB(B0, 1, 0); PG8_LDB(B1, 1, 1); PG8_SCHED; PG8_LDA(At, 1, 0); PG8_STAGE(PG8_SA(0, 1), a2 + hstep, voffA);
            PG8_WAIT_V(8); PG8_WAIT_L(0); PG8_BAR; PG8_MMA(0, 0, At, B0); PG8_MMA(0, 1, At, B1); PG8_BAR; PG8_SCHED;
            PG8_LDA(At, 1, 1); PG8_STAGE(PG8_SB(1, 0), b3, voffB); PG8_STAGE(PG8_SB(1, 1), b3 + hstep, voffB); PG8_STAGE(PG8_SA(1, 0), a3, voffA);
            PG8_WAIT_V(8); PG8_WAIT_L(0); PG8_BAR; PG8_MMA(1, 0, At, B0); PG8_MMA(1, 1, At, B1); PG8_BAR; PG8_SCHED;
        }
        if constexpr (ALIGN_EPI) { if (wr == 0) PG8_BAR; }
        if constexpr (!Epi::AFTER_DRAIN) { E(acc, cur, wr, wc, fr, fq); S.done(cur); }
        if (!has_next) break;
#pragma unroll
        for (int a = 0; a < 2; ++a)
#pragma unroll
            for (int b = 0; b < 2; ++b)
#pragma unroll
                for (int m = 0; m < 4; ++m)
#pragma unroll
                    for (int n = 0; n < 2; ++n) acc[a][b][m][n] = (f32x4){0.f, 0.f, 0.f, 0.f};
        cur = nxt; cA = nA; cB = nB; ++ui;
        if constexpr (ALIGN_EPI) { if (wr == 1) PG8_BAR; }
    }
    PG8_WAIT_V(0);
    if constexpr (!ALIGN_EPI) { if (wr == 0) PG8_BAR; }
    PG8_BAR;
    if constexpr (Epi::AFTER_DRAIN) { E.fused(acc, cur, wr, wc, fr, fq, lds, wid, lane); S.done(cur); }
#undef PG8_SA
#undef PG8_SB
#undef PG8_STAGE
#undef PG8_LDA
#undef PG8_LDB
#undef PG8_MMA
#undef PG8_WAIT_V
#undef PG8_WAIT_L
#undef PG8_BAR
#undef PG8_SCHED
}
}
#define GAS __attribute__((address_space(1)))
#define LAS __attribute__((address_space(3)))
typedef unsigned short bf16;
typedef unsigned v4u __attribute__((ext_vector_type(4)));
typedef float f32x4 __attribute__((ext_vector_type(4)));
typedef short bf16x8 __attribute__((ext_vector_type(8)));
typedef GAS unsigned gu32;
#define RLX_AGENT __ATOMIC_RELAXED, __HIP_MEMORY_SCOPE_AGENT
#define LDS_WAIT() asm volatile("s_waitcnt lgkmcnt(0)" ::: "memory")
#define VM_WAIT() asm volatile("s_waitcnt vmcnt(0)" ::: "memory")
__device__ __forceinline__ unsigned f2bf(float f) { unsigned u = __builtin_bit_cast(unsigned, f); return (u + 0x7fffu + ((u >> 16) & 1u)) >> 16; }
__device__ __forceinline__ unsigned pk2(float lo, float hi) { return f2bf(lo) | (f2bf(hi) << 16); }
__device__ __forceinline__ float bf2f(bf16 b) { return __builtin_bit_cast(float, (unsigned)b << 16); }
__device__ __forceinline__ float wave_sum(float v, int lane) {
#pragma unroll
    for (int o = 1; o < 64; o <<= 1) v += pg8::shx(v, lane, o);
    return v;
}
__device__ __forceinline__ int lane_now() { int l; asm volatile("v_mbcnt_lo_u32_b32 %0, -1, 0\n\tv_mbcnt_hi_u32_b32 %0, -1, %0" : "=v"(l)); return l; }
__device__ __forceinline__ float silu_f(float x) { return x / (1.f + __expf(-x)); }

#define XB_TMO      128
#define XB_XCNT(j)  (256  + 64 * (j))
#define XB_XSUB(j)  (1280 + 64 * (j))
#define XB_XGEN(j)  (2304 + 64 * (j))
#define XB_TOP      3328
#define XB_TOPGEN   3392
#define XCD_BAR_WORDS 3456
#define XB_SPIN_CAP (1u << 24)

__device__ __forceinline__ unsigned xb_ld(unsigned* p)              { return __hip_atomic_load(p, __ATOMIC_RELAXED, __HIP_MEMORY_SCOPE_AGENT); }
__device__ __forceinline__ unsigned xb_add(unsigned* p, unsigned v) { return __hip_atomic_fetch_add(p, v, __ATOMIC_RELAXED, __HIP_MEMORY_SCOPE_AGENT); }
__device__ __forceinline__ unsigned xb_xcc_id() { return (unsigned)__builtin_amdgcn_s_getreg((3 << 11) | 20) & 0xFu; }
#define XB_SPIN(cond, bar) do { while (cond) { __builtin_amdgcn_s_sleep(1); } } while (0)

struct XcdBarrier {
    unsigned* bar; unsigned x;
    volatile LAS unsigned* st;
};

__device__ __forceinline__ XcdBarrier xcd_barrier_post(unsigned* bar, volatile LAS unsigned* st, int tid) {
    XcdBarrier b; b.bar = bar; b.x = xb_xcc_id(); b.st = st;
    if (tid == 0) (void)xb_add(&bar[XB_XCNT(b.x)], 1u);
    return b;
}
__device__ __forceinline__ void xcd_barrier_complete(unsigned* bar, unsigned x, unsigned& nloc, unsigned& nx) {
    const unsigned G = gridDim.x * gridDim.y * gridDim.z;
    unsigned sum, cnt, mine;
    for (;;) {
        sum = 0u; cnt = 0u; mine = 0u;
#pragma unroll
        for (unsigned j = 0; j < 16; ++j) { const unsigned c = xb_ld(&bar[XB_XCNT(j)]); sum += c; cnt += (c > 0u) ? 1u : 0u; mine = (j == x) ? c : mine; }
        if (sum == G) break;
        __builtin_amdgcn_s_sleep(1);
    }
    nloc = mine > 0u ? mine : 1u; nx = cnt > 0u ? cnt : 1u;
}

__device__ __forceinline__ void xcd_barrier(const XcdBarrier& b, int tid) {
    asm volatile("s_waitcnt vmcnt(0)" ::: "memory");
    __syncthreads();
    if (tid == 0) {
        unsigned* bar = b.bar;
        __builtin_amdgcn_s_waitcnt(0);
        unsigned nloc = b.st[0], nx = b.st[1];
        if (nloc == 0u) { xcd_barrier_complete(bar, b.x, nloc, nx); b.st[0] = nloc; b.st[1] = nx; }
        const unsigned old = xb_add(&bar[XB_XSUB(b.x)], 1u);
        const unsigned gen = old / nloc;
        if (old + 1u == (gen + 1u) * nloc) {
            __builtin_amdgcn_fence(__ATOMIC_RELEASE, "agent");
            asm volatile("s_waitcnt vmcnt(0)" ::: "memory");
            const unsigned og = xb_add(&bar[XB_TOP], 1u);
            const unsigned tg = og / nx;
            if (og + 1u == (tg + 1u) * nx) xb_add(&bar[XB_TOPGEN], 1u);
            else XB_SPIN(xb_ld(&bar[XB_TOPGEN]) == tg, bar);
            __builtin_amdgcn_fence(__ATOMIC_ACQUIRE, "agent");
            xb_add(&bar[XB_XGEN(b.x)], 1u);
            asm volatile("s_waitcnt vmcnt(0)" ::: "memory");
        } else {
            XB_SPIN(xb_ld(&bar[XB_XGEN(b.x)]) == gen, bar);
            __builtin_amdgcn_fence(__ATOMIC_ACQUIRE, "agent");
            asm volatile("s_waitcnt vmcnt(0)" ::: "memory");
        }
    }
    __syncthreads();
}


constexpr int NWAVES = 8;
constexpr int M = 16384, SEQ = 8192, D = 1024, FF = 4096, NPROJ = 2560, IN_W = 2472;
constexpr float EPS = 1e-6f;
constexpr int R_CQ = 0, R_CKV = 256, R_KR = 384, R_GA = 416, R_GB = 420;

constexpr size_t MiB = 1u << 20, KiB = 1u << 10;
constexpr size_t WS_CTL = 0, CTL_ZERO_BYTES = 1 * MiB;
constexpr size_t WS_WIN = 1 * MiB, WS_WQ = 11 * MiB, WS_WKV = 11 * MiB + 768 * KiB, WS_WOUT = 13 * MiB, WS_WUP = 17 * MiB, WS_WDN = 33 * MiB;
constexpr size_t WS_COS = 49 * MiB, WS_SIN = 50 * MiB;
constexpr size_t WS_RSQ = 51 * MiB, WS_RSKV = 51 * MiB + 64 * KiB, WS_BETA = 51 * MiB + 128 * KiB, WS_LOGA = 51 * MiB + 384 * KiB;
constexpr size_t WS_XN = 52 * MiB, WS_REST = 84 * MiB, WS_OPSX = 100 * MiB, WS_GG = 125 * MiB, WS_GQ = 141 * MiB, WS_GK = 157 * MiB, WS_GV = 173 * MiB;
constexpr size_t WS_Q = 189 * MiB, WS_K = 213 * MiB, WS_V = 237 * MiB, WS_END = 256 * MiB;
constexpr size_t WS_CAT = WS_GQ, WS_H = 125 * MiB, WS_OPS = 52 * MiB;
constexpr size_t WS_NQ = 52 * MiB, WS_NK = 68 * MiB, WS_NV = 100 * MiB, WS_ORAW = WS_GV, WS_MIXED = 189 * MiB, WS_F = 52 * MiB, WS_XN1 = WS_XN, WS_R3 = 84 * MiB;
constexpr size_t WS_CQN = 100 * MiB, WS_CKVN = 108 * MiB;
constexpr size_t WS_XCH = 253 * MiB;
constexpr int CW_BAR = 4096, CW_TMO = 0, CW_SEAM = 16384, SEAM_BANK = 64 * 64;

constexpr int RING_OFF = 0, RING_BYTES = 162816;
constexpr int LDSCTL_OFF = RING_BYTES, MISC_OFF = LDSCTL_OFF + 320;
constexpr int LDS_BYTES = 163840;

struct Args {
    const float* x; const int* pos; const float* mix_pre; const float* w_in; const float* conv_w; const float* a_log; const float* dt_bias; const float* gdn_norm;
    const float* q_norm; const float* w_q_up; const float* kv_norm; const float* w_kv_up; const float* w_out; const float* mix_post; const float* ffn_pre; const float* w_up; const float* w_down; const float* ffn_post;
    float* out; unsigned char* ws; int ph_lo, ph_hi;
};
struct Frame { LAS unsigned char* lds; int tid, lane, wave, vcu, G, gw, NGW; };

template <class MapF>
__device__ __forceinline__ void p0_transpose_item(const float* W, int K, int N, int nblk, bf16* WT, const float* kgain, int glim, int gmask, LAS float* scr, int item, int lane, MapF srcmap) {
    const int kb = item / nblk, nb = item % nblk, k0 = 64 * kb, n0 = 32 * nb;
    const int src = srcmap(n0 + (lane & 31));
    float wv[32];
#pragma unroll
    for (int i = 0; i < 32; ++i) { const int kk = 2 * i + (lane >> 5); wv[i] = src >= 0 ? W[(size_t)(k0 + kk) * N + src] : 0.f; }
#pragma unroll
    for (int i = 0; i < 32; ++i) { const int kk = 2 * i + (lane >> 5); float v = wv[i]; if (kgain && k0 + kk < glim) v *= kgain[(k0 + kk) & gmask]; scr[kk * 33 + (lane & 31)] = v; }
    LDS_WAIT(); asm volatile("" ::: "memory");
    const int c = lane & 7;
#pragma unroll
    for (int j = 0; j < 4; ++j) { const int n = (lane >> 3) + 8 * j; const LAS float* s = scr + (8 * c) * 33 + n;
        v4u o; o.x = pk2(s[0 * 33], s[1 * 33]); o.y = pk2(s[2 * 33], s[3 * 33]); o.z = pk2(s[4 * 33], s[5 * 33]); o.w = pk2(s[6 * 33], s[7 * 33]);
        *(GAS v4u*)(WT + (size_t)(n0 + n) * K + k0 + 8 * c) = o; }
    LDS_WAIT(); asm volatile("" ::: "memory");
}
struct MapId { __device__ __forceinline__ int operator()(int n) const { return n; } };
struct MapWin { __device__ __forceinline__ int operator()(int n) const { return n < 2048 ? n : (n < 2464 ? n + 8 : (n < 2472 ? n - 2464 + 2048 : -1)); } };

__device__ __forceinline__ void rms_row_to_bf16(int lane, const float* xrow, const float* gain, bf16* orow) {
    const GAS f32x4* xr = (const GAS f32x4*)xrow + lane; const f32x4* gr = (const f32x4*)gain + lane;
    f32x4 v[4]; float s = 0.f;
#pragma unroll
    for (int j = 0; j < 4; ++j) { v[j] = xr[64 * j]; s += (v[j].x * v[j].x + v[j].y * v[j].y) + (v[j].z * v[j].z + v[j].w * v[j].w); }
    const float rstd = rsqrtf(wave_sum(s, lane) * (1.f / D) + EPS);
    GAS unsigned long long* o8 = (GAS unsigned long long*)orow + lane;
#pragma unroll
    for (int j = 0; j < 4; ++j) { const f32x4 g = gr[64 * j]; o8[64 * j] = (unsigned long long)pk2(v[j].x * rstd * g.x, v[j].y * rstd * g.y) | ((unsigned long long)pk2(v[j].z * rstd * g.z, v[j].w * rstd * g.w) << 32); }
}
template <int R>
__device__ __forceinline__ void rms_rows_to_bf16(int lane, const float* xrow, size_t rstride, const float* gain, bf16* orow) {
    f32x4 v[R][4]; float s[R];
#pragma unroll
    for (int r = 0; r < R; ++r) { const GAS f32x4* xr = (const GAS f32x4*)(xrow + r * rstride) + lane; s[r] = 0.f;
#pragma unroll
        for (int j = 0; j < 4; ++j) v[r][j] = xr[64 * j]; }
#pragma unroll
    for (int r = 0; r < R; ++r)
#pragma unroll
        for (int j = 0; j < 4; ++j) s[r] += (v[r][j].x * v[r][j].x + v[r][j].y * v[r][j].y) + (v[r][j].z * v[r][j].z + v[r][j].w * v[r][j].w);
#pragma unroll
    for (int o = 1; o < 64; o <<= 1)
#pragma unroll
        for (int r = 0; r < R; ++r) s[r] += pg8::shx(s[r], lane, o);
    const f32x4* gr = (const f32x4*)gain + lane;
#pragma unroll
    for (int r = 0; r < R; ++r) { const float rstd = rsqrtf(s[r] * (1.f / D) + EPS); GAS unsigned long long* o8 = (GAS unsigned long long*)(orow + r * rstride) + lane;
#pragma unroll
        for (int j = 0; j < 4; ++j) { const f32x4 g = gr[64 * j]; o8[64 * j] = (unsigned long long)pk2(v[r][j].x * rstd * g.x, v[r][j].y * rstd * g.y) | ((unsigned long long)pk2(v[r][j].z * rstd * g.z, v[r][j].w * rstd * g.w) << 32); } }
}
__device__ __forceinline__ void resid_norm_row(int lane, const float* xi, const float* y, const float* g1, float* xo, const float* g2, bf16* xn) {
    const f32x4* yr = (const f32x4*)y + lane; const f32x4* xr = (const f32x4*)xi + lane; const f32x4* g1r = (const f32x4*)g1 + lane;
    f32x4 v[4]; float s = 0.f;
#pragma unroll
    for (int j = 0; j < 4; ++j) { v[j] = yr[64 * j]; s += (v[j].x * v[j].x + v[j].y * v[j].y) + (v[j].z * v[j].z + v[j].w * v[j].w); }
    const float r = rsqrtf(wave_sum(s, lane) * (1.f / D) + EPS);
    float s2 = 0.f;
#pragma unroll
    for (int j = 0; j < 4; ++j) { v[j] = xr[64 * j] + v[j] * r * g1r[64 * j]; s2 += (v[j].x * v[j].x + v[j].y * v[j].y) + (v[j].z * v[j].z + v[j].w * v[j].w); }
#pragma unroll
    for (int j = 0; j < 4; ++j) ((f32x4*)xo + lane)[64 * j] = v[j];
    if (g2) {
        const float r2 = rsqrtf(wave_sum(s2, lane) * (1.f / D) + EPS);
        unsigned long long* o8 = (unsigned long long*)xn + lane;
#pragma unroll
        for (int j = 0; j < 4; ++j) { const f32x4 g = ((const f32x4*)g2 + lane)[64 * j]; o8[64 * j] = (unsigned long long)pk2(v[j].x * r2 * g.x, v[j].y * r2 * g.y) | ((unsigned long long)pk2(v[j].z * r2 * g.z, v[j].w * r2 * g.w) << 32); }
    }
}
namespace att {
typedef __attribute__((ext_vector_type(8))) short bf16x8;
typedef __attribute__((ext_vector_type(4))) short s16x4;
typedef __attribute__((ext_vector_type(16))) float f32x16;
typedef __attribute__((ext_vector_type(4))) unsigned u32x4;
constexpr int QP = 768, KP = 768, VP = 512, OP = 1024, SEQL = 8192;
constexpr int NW = 8, QBLK = 32, QB = 256, KVBLK = 64;
constexpr int NSLOT = 4, KSLOT = 12288, VSLOT = 8192;
constexpr int LDS_K = 0, LDS_V = NSLOT * KSLOT, LDS_WS = LDS_V + NSLOT * VSLOT, LDS_OST = LDS_WS + NW * 64 * 4, LDS_BYTES = LDS_OST + NW * 4096;
__device__ __forceinline__ int crow(int r, int hi) { return (r & 3) + 8 * (r >> 2) + 4 * hi; }
__device__ __forceinline__ void glds16(const void* gsrc, unsigned lds_dst) { unsigned keep;
    asm volatile("s_mov_b32 %0, m0\n\ts_mov_b32 m0, %2\n\ts_nop 0\n\tglobal_load_lds_dwordx4 %1, off\n\ts_mov_b32 m0, %0" : "=&s"(keep) : "v"(gsrc), "s"(lds_dst) : "memory"); }
typedef float f32x2_t __attribute__((ext_vector_type(2))); typedef __bf16 bf16x2_t __attribute__((ext_vector_type(2)));
__device__ __forceinline__ unsigned cvtpk_s(float lo, float hi) { f32x2_t v = {lo, hi}; bf16x2_t b = __builtin_convertvector(v, bf16x2_t); return __builtin_bit_cast(unsigned, b); }
#define ATT_WAIT_BAR(N) asm volatile("s_waitcnt vmcnt(" #N ") lgkmcnt(0)\n\ts_barrier" ::: "memory")
typedef __attribute__((address_space(3))) const char* lds_cptr;

#define ATT_SBAR() __builtin_amdgcn_sched_barrier(0)
#define ATT_PIN(x) asm volatile("" : "+v"(x))
#define ATT_MFMA(a, b, c) __builtin_amdgcn_mfma_f32_32x32x16_bf16(a, b, c, 0, 0, 0)
#define ATT_THR 8.0f
typedef short v4i16_t __attribute__((ext_vector_type(4)));
__device__ __forceinline__ void kload2(bf16x8* kf, lds_cptr kp, int d0) { kf[2 * d0] = *(const __attribute__((address_space(3))) bf16x8*)(kp + d0 * 2048); kf[2 * d0 + 1] = *(const __attribute__((address_space(3))) bf16x8*)(kp + d0 * 2048 + 512); }
__device__ __forceinline__ s16x4 vtr(lds_cptr p) { return __builtin_bit_cast(s16x4, __builtin_amdgcn_ds_read_tr16_b64_v4i16((__attribute__((address_space(3))) v4i16_t*)p)); }
#define ATT_MX3(a, b, c) __builtin_fmaxf(__builtin_fmaxf((a), (b)), (c))
__device__ __forceinline__ float rowmax(const f32x16& p0, const f32x16& p1) {
    float a = ATT_MX3(p0[0], p0[1], p1[0]), b = ATT_MX3(p0[2], p0[3], p1[1]); a = ATT_MX3(a, p1[2], p1[3]);
#pragma unroll
    for (int r = 4; r < 16; r += 4) { a = ATT_MX3(a, p0[r], p0[r + 1]); b = ATT_MX3(b, p0[r + 2], p0[r + 3]); a = ATT_MX3(a, p1[r], p1[r + 1]); b = ATT_MX3(b, p1[r + 2], p1[r + 3]); }
    float m = __builtin_fmaxf(a, b); auto rr = __builtin_amdgcn_permlane32_swap(__float_as_uint(m), __float_as_uint(m), false, false);
    return __builtin_fmaxf(__uint_as_float(rr[0]), __uint_as_float(rr[1])); }

template <int AM>
__device__ __forceinline__ void attn_unit(int b, int h, int qb, const unsigned short* Q, const unsigned short* K, const unsigned short* V, unsigned short* O, const float* ctab, const float* stab, char* shm, int tid_in) {
    int tid_ = tid_in; asm volatile("" : "+v"(tid_));
    const int tid = tid_, lane = tid & 63, r32 = lane & 31, hi = lane >> 5; const int wid = __builtin_amdgcn_readfirstlane(tid >> 6);
    const long rowbase = (long)b * SEQL; const int q0 = qb * QB;
    const unsigned short* Qw = Q + (rowbase + q0 + wid * QBLK) * QP + h * 96;
    const unsigned short* Kh = K + rowbase * KP + h * 96; const unsigned short* Vh = V + rowbase * VP + h * 64;
    const unsigned lds0 = (unsigned)(uintptr_t)shm;
    __attribute__((address_space(3))) float* wsf = (__attribute__((address_space(3))) float*)(shm + LDS_WS) + wid * 64;
    const unsigned short* ksrc0 = Kh + (long)lane * KP + wid * 8;
    const unsigned short* ksrc1 = Kh + (long)lane * KP + (8 + (wid & 3)) * 8;
    const unsigned short* vsrc = Vh + (long)(16 * (wid & 3) + (lane >> 2)) * VP + (wid >> 2) * 32 + (lane & 3) * 8;
    const unsigned kdst0 = lds0 + LDS_K + wid * 1024, kdst1 = lds0 + LDS_K + (8 + (wid & 3)) * 1024, vdst = lds0 + LDS_V + wid * 1024;
    const bool two = wid < 4;
#define ATT_DMAK(t, s) do { glds16(ksrc0 + (long)(t) * KVBLK * KP, (unsigned)__builtin_amdgcn_readfirstlane(kdst0 + (s) * KSLOT)); \
        if (two) glds16(ksrc1 + (long)(t) * KVBLK * KP, (unsigned)__builtin_amdgcn_readfirstlane(kdst1 + (s) * KSLOT)); } while (0)
#define ATT_DMAV(t, s) glds16(vsrc + (long)(t) * KVBLK * VP, (unsigned)__builtin_amdgcn_readfirstlane(vdst + (s) * VSLOT))
    const lds_cptr vp0 = (lds_cptr)(shm + LDS_V) + ((lane >> 4) & 1) * 32 + (lane & 3) * 8 + (4 * hi + ((lane & 15) >> 2)) * 64;
    const lds_cptr kp0 = (lds_cptr)(shm + LDS_K) + hi * 1024 + r32 * 16;
    const int NT = (q0 + QB) / KVBLK;
    const int tvis = 4 * qb + (wid >> 1);
    ATT_DMAK(0, 0); ATT_DMAK(1, 1); ATT_DMAV(0, 0);
    bf16x8 qr[6];
#pragma unroll
    for (int d0 = 0; d0 < 6; ++d0) qr[d0] = *reinterpret_cast<const bf16x8*>(&Qw[(long)r32 * QP + d0 * 16 + hi * 8]);
    {
        const long mrow = rowbase + q0 + wid * QBLK + r32;
        const float* cp = ctab + mrow * 16 + 8 * hi; const float* sp = stab + mrow * 16 + 8 * hi;
        float c[8], s[8];
#pragma unroll
        for (int e = 0; e < 8; ++e) { c[e] = cp[e]; s[e] = sp[e]; }
        u32x4 a4 = __builtin_bit_cast(u32x4, qr[4]), a5 = __builtin_bit_cast(u32x4, qr[5]), n4, n5;
#pragma unroll
        for (int w = 0; w < 4; ++w) {
            const float x1l = __builtin_bit_cast(float, a4[w] << 16), x1h = __builtin_bit_cast(float, a4[w] & 0xffff0000u), x2l = __builtin_bit_cast(float, a5[w] << 16), x2h = __builtin_bit_cast(float, a5[w] & 0xffff0000u);
            n4[w] = cvtpk_s(x1l * c[2 * w] - x2l * s[2 * w], x1h * c[2 * w + 1] - x2h * s[2 * w + 1]);
            n5[w] = cvtpk_s(x2l * c[2 * w] + x1l * s[2 * w], x2h * c[2 * w + 1] + x1h * s[2 * w + 1]); }
        qr[4] = __builtin_bit_cast(bf16x8, n4); qr[5] = __builtin_bit_cast(bf16x8, n5);
    }
#pragma unroll
    for (int d0 = 0; d0 < 6; ++d0) ATT_PIN(qr[d0]);
    ATT_DMAK(2, 2); ATT_DMAV(1, 1); ATT_DMAK(3, 3); ATT_DMAV(2, 2);
    float mhat = 0.f, l_reg = 0.f; f32x16 o[2]; o[0] = f32x16{}; o[1] = f32x16{};
    f32x16 negm16 = f32x16{}; ATT_PIN(negm16);
    bool resc = false;
    f32x16 pA0, pA1, pB0, pB1; bf16x8 kf[12]; s16x4 vlo[8], vhi[8]; u32x4 pw0, pw1, pw2, pw3;
#define ATT_RESC() do { if (resc) { const int hi_ = lane_now() >> 5; _Pragma("unroll") for (int r = 0; r < 16; ++r) { const float f_ = wsf[crow(r, hi_)]; o[0][r] *= f_; o[1][r] *= f_; } } } while (0)
    if (two) ATT_WAIT_BAR(6); else ATT_WAIT_BAR(4);
    _Pragma("unroll") for (int d0 = 0; d0 < 6; ++d0) kload2(kf, kp0, d0);
    pA0 = ATT_MFMA(kf[0], qr[0], negm16); pA1 = ATT_MFMA(kf[1], qr[0], negm16);
    _Pragma("unroll") for (int d0 = 1; d0 < 6; ++d0) { pA0 = ATT_MFMA(kf[2 * d0], qr[d0], pA0); pA1 = ATT_MFMA(kf[2 * d0 + 1], qr[d0], pA1); }
    { const float rm = rowmax(pA0, pA1); mhat = rm;
#pragma unroll
      for (int r = 0; r < 16; ++r) { pA0[r] = __builtin_amdgcn_exp2f(pA0[r] - rm); pA1[r] = __builtin_amdgcn_exp2f(pA1[r] - rm); }
#pragma unroll
      for (int r = 0; r < 16; ++r) negm16[r] = -rm;
      ATT_PIN(negm16); }
    if (two) ATT_WAIT_BAR(4); else ATT_WAIT_BAR(3);
    _Pragma("unroll") for (int d0 = 0; d0 < 6; ++d0) kload2(kf, kp0 + KSLOT, d0);
#define ATT_PKW(P, i) cvtpk_s(P[i], P[(i) + 1])
#define ATT_PAF(k) __builtin_bit_cast(bf16x8, pw##k)
#define ATT_VFR(i) (bf16x8){vlo[i][0], vlo[i][1], vlo[i][2], vlo[i][3], vhi[i][0], vhi[i][1], vhi[i][2], vhi[i][3]}
#define ATT_VRD(i) do { vlo[i] = vtr(vp_ + (((i) >> 2) * 4096 + ((i) & 3) * 1024)); vhi[i] = vtr(vp_ + (((i) >> 2) * 4096 + ((i) & 3) * 1024 + 512)); ATT_SBAR(); } while (0)
#define ATT_KRD(G, d0) do { if (G) { kload2(kf, kn_, d0); ATT_SBAR(); } } while (0)
#define ATT_GAPA(MF, ADDS, PK, PW) do { MF; ADDS; PK; ATT_PIN(PW); ATT_PIN(sacc); ATT_SBAR(); } while (0)
#define ATT_GAPB(MF, X, i) do { MF; X[i] = __builtin_amdgcn_exp2f(X[i]); X[(i) + 1] = __builtin_amdgcn_exp2f(X[(i) + 1]); X[(i) + 2] = __builtin_amdgcn_exp2f(X[(i) + 2]); X[(i) + 3] = __builtin_amdgcn_exp2f(X[(i) + 3]); ATT_PIN(X); ATT_SBAR(); } while (0)
#define ATT_STEP(C0, C1, P0, P1, t, MASK, GK, GV, GL) do { ATT_SBAR(); \
    const lds_cptr vp_ = vp0 + (((t) - 1) & 3) * VSLOT; const lds_cptr kn_ = kp0 + (((t) + 1) & 3) * KSLOT; \
    float sacc = P0[0] + P0[1]; \
    ATT_GAPA(C0 = ATT_MFMA(kf[0], qr[0], negm16), sacc += P0[2]; sacc += P0[3]; sacc += P0[4],    pw0[0] = ATT_PKW(P0, 0), pw0); \
    ATT_GAPA(C1 = ATT_MFMA(kf[1], qr[0], negm16), sacc += P0[5]; sacc += P0[6]; sacc += P0[7],    pw0[1] = ATT_PKW(P0, 2), pw0); \
    ATT_GAPA(C0 = ATT_MFMA(kf[2], qr[1], C0),     sacc += P0[8]; sacc += P0[9]; sacc += P0[10],   pw0[2] = ATT_PKW(P0, 4), pw0); \
    ATT_GAPA(C1 = ATT_MFMA(kf[3], qr[1], C1),     sacc += P0[11]; sacc += P0[12]; sacc += P0[13], pw0[3] = ATT_PKW(P0, 6), pw0); \
    ATT_GAPA(C0 = ATT_MFMA(kf[4], qr[2], C0),     sacc += P0[14]; sacc += P0[15]; sacc += P1[0],  pw1[0] = ATT_PKW(P0, 8), pw1); \
    ATT_GAPA(C1 = ATT_MFMA(kf[5], qr[2], C1),     sacc += P1[1]; sacc += P1[2]; sacc += P1[3],    pw1[1] = ATT_PKW(P0, 10), pw1); \
    ATT_GAPA(C0 = ATT_MFMA(kf[6], qr[3], C0),     sacc += P1[4]; sacc += P1[5]; sacc += P1[6],    pw1[2] = ATT_PKW(P0, 12); pw2[0] = ATT_PKW(P1, 0), pw1); \
    ATT_GAPA(C1 = ATT_MFMA(kf[7], qr[3], C1),     sacc += P1[7]; sacc += P1[8]; sacc += P1[9],    pw1[3] = ATT_PKW(P0, 14); pw2[1] = ATT_PKW(P1, 2), pw1); \
    ATT_VRD(0); ATT_GAPA(C0 = ATT_MFMA(kf[8], qr[4], C0),   sacc += P1[10]; sacc += P1[11],  pw2[2] = ATT_PKW(P1, 4); pw2[3] = ATT_PKW(P1, 6), pw2); \
    ATT_VRD(4); ATT_GAPA(C1 = ATT_MFMA(kf[9], qr[4], C1),   sacc += P1[12]; sacc += P1[13],  pw3[0] = ATT_PKW(P1, 8); pw3[1] = ATT_PKW(P1, 10), pw3); \
    ATT_VRD(1); ATT_GAPA(C0 = ATT_MFMA(kf[10], qr[5], C0),  sacc += P1[14],                  pw3[2] = ATT_PKW(P1, 12), pw3); \
    ATT_VRD(5); ATT_GAPA(C1 = ATT_MFMA(kf[11], qr[5], C1),  sacc += P1[15],                  pw3[3] = ATT_PKW(P1, 14), pw3); \
    l_reg += sacc; \
    if (GK) ATT_DMAK((t) + 3, ((t) + 3) & 3); if (GV) ATT_DMAV((t) + 2, ((t) + 2) & 3); \
    if (MASK) { if ((t) > tvis) { _Pragma("unroll") for (int r = 0; r < 16; ++r) { C0[r] = -INFINITY; C1[r] = -INFINITY; } } } \
    { const float rm = rowmax(C0, C1); resc = false;                                                   \
      if (__builtin_expect(__any(rm > ATT_THR), 0)) { const float dl = __builtin_fmaxf(rm, 0.f); mhat += dl;                                \
          const float f = __builtin_amdgcn_exp2f(-dl); l_reg *= f; { const int ln_ = lane_now(); if (ln_ < 32) wsf[ln_] = f; } resc = true; \
          _Pragma("unroll") for (int r = 0; r < 16; ++r) { C0[r] -= dl; C1[r] -= dl; negm16[r] = -mhat; } ATT_PIN(negm16); } } \
    ATT_SBAR(); \
    ATT_VRD(2);                 ATT_GAPB(o[0] = ATT_MFMA(ATT_PAF(0), ATT_VFR(0), o[0]), C0, 0); \
    ATT_VRD(6); ATT_KRD(GL, 0); ATT_GAPB(o[1] = ATT_MFMA(ATT_PAF(0), ATT_VFR(4), o[1]), C0, 4); \
    ATT_VRD(3); ATT_KRD(GL, 1); ATT_GAPB(o[0] = ATT_MFMA(ATT_PAF(1), ATT_VFR(1), o[0]), C0, 8); \
    ATT_VRD(7); ATT_KRD(GL, 2); ATT_GAPB(o[1] = ATT_MFMA(ATT_PAF(1), ATT_VFR(5), o[1]), C0, 12); \
                ATT_KRD(GL, 3); ATT_GAPB(o[0] = ATT_MFMA(ATT_PAF(2), ATT_VFR(2), o[0]), C1, 0); \
                ATT_KRD(GL, 4); ATT_GAPB(o[1] = ATT_MFMA(ATT_PAF(2), ATT_VFR(6), o[1]), C1, 4); \
                ATT_KRD(GL, 5); ATT_GAPB(o[0] = ATT_MFMA(ATT_PAF(3), ATT_VFR(3), o[0]), C1, 8); \
                                ATT_GAPB(o[1] = ATT_MFMA(ATT_PAF(3), ATT_VFR(7), o[1]), C1, 12); \
    } while (0)
#define ATT_ENDW(tt) do { if ((tt) + 3 < NT) { if (two) ATT_WAIT_BAR(4); else ATT_WAIT_BAR(3); } else ATT_WAIT_BAR(0); } while (0)
    int t = 1;
    for (; t + 5 < NT; t += 2) {
        ATT_STEP(pB0, pB1, pA0, pA1, t, false, true, true, true);     if (two) ATT_WAIT_BAR(4); else ATT_WAIT_BAR(3); ATT_RESC();
        ATT_STEP(pA0, pA1, pB0, pB1, t + 1, false, true, true, true); if (two) ATT_WAIT_BAR(4); else ATT_WAIT_BAR(3); ATT_RESC();
    }
    for (; t + 1 < NT; t += 2) {
        ATT_STEP(pB0, pB1, pA0, pA1, t, true, (t + 3 < NT), (t + 2 < NT), (t + 1 < NT));     ATT_ENDW(t);     ATT_RESC();
        ATT_STEP(pA0, pA1, pB0, pB1, t + 1, true, (t + 4 < NT), (t + 3 < NT), (t + 2 < NT)); ATT_ENDW(t + 1); ATT_RESC();
    }
    ATT_STEP(pB0, pB1, pA0, pA1, NT - 1, true, false, false, false); ATT_RESC();
    { float sacc = pB0[0] + pB0[1];
#pragma unroll
      for (int r = 2; r < 16; ++r) sacc += pB0[r];
#pragma unroll
      for (int r = 0; r < 16; ++r) sacc += pB1[r];
      l_reg += sacc;
      pw0 = (u32x4){ATT_PKW(pB0, 0), ATT_PKW(pB0, 2), ATT_PKW(pB0, 4), ATT_PKW(pB0, 6)}; pw1 = (u32x4){ATT_PKW(pB0, 8), ATT_PKW(pB0, 10), ATT_PKW(pB0, 12), ATT_PKW(pB0, 14)};
      pw2 = (u32x4){ATT_PKW(pB1, 0), ATT_PKW(pB1, 2), ATT_PKW(pB1, 4), ATT_PKW(pB1, 6)}; pw3 = (u32x4){ATT_PKW(pB1, 8), ATT_PKW(pB1, 10), ATT_PKW(pB1, 12), ATT_PKW(pB1, 14)};
      const lds_cptr vp_ = vp0 + ((NT - 1) & 3) * VSLOT; _Pragma("unroll") for (int i = 0; i < 8; ++i) ATT_VRD(i);
      o[0] = ATT_MFMA(ATT_PAF(0), ATT_VFR(0), o[0]); o[1] = ATT_MFMA(ATT_PAF(0), ATT_VFR(4), o[1]); o[0] = ATT_MFMA(ATT_PAF(1), ATT_VFR(1), o[0]); o[1] = ATT_MFMA(ATT_PAF(1), ATT_VFR(5), o[1]);
      o[0] = ATT_MFMA(ATT_PAF(2), ATT_VFR(2), o[0]); o[1] = ATT_MFMA(ATT_PAF(2), ATT_VFR(6), o[1]); o[0] = ATT_MFMA(ATT_PAF(3), ATT_VFR(3), o[0]); o[1] = ATT_MFMA(ATT_PAF(3), ATT_VFR(7), o[1]); }
    { auto rr = __builtin_amdgcn_permlane32_swap(__float_as_uint(l_reg), __float_as_uint(l_reg), false, false); l_reg = __uint_as_float(rr[0]) + __uint_as_float(rr[1]); }
    if (hi == 0) wsf[32 + r32] = l_reg;
    asm volatile("s_waitcnt lgkmcnt(0)" ::: "memory");
    float rli[16];
#pragma unroll
    for (int r = 0; r < 16; ++r) rli[r] = __builtin_amdgcn_rcpf(wsf[32 + crow(r, hi)]);
    unsigned short* Ow = O + (rowbase + q0 + wid * QBLK) * OP + 512 + h * 64;
    { __attribute__((address_space(3))) unsigned short* stg = (__attribute__((address_space(3))) unsigned short*)(shm + LDS_OST) + wid * 2048;
#pragma unroll
      for (int r = 0; r < 16; ++r) { const int orow = crow(r, hi);
#pragma unroll
          for (int d0 = 0; d0 < 2; ++d0) stg[orow * 64 + d0 * 32 + r32] = (unsigned short)(cvtpk_s(o[d0][r] * rli[r], 0.f) & 0xffffu); }
      asm volatile("s_waitcnt lgkmcnt(0)" ::: "memory");
#pragma unroll
      for (int i = 0; i < 4; ++i) { const int row = i * 8 + (lane >> 3), ch = lane & 7; const u32x4 v = *(const __attribute__((address_space(3))) u32x4*)(stg + row * 64 + ch * 8); if (!(AM & 1)) *(u32x4*)(Ow + (long)row * OP + ch * 8) = v; else asm volatile("" :: "v"(v)); } }
    asm volatile("s_waitcnt lgkmcnt(0)\n\ts_barrier" ::: "memory");
#undef ATT_DMAK
#undef ATT_DMAV
#undef ATT_RESC
#undef ATT_PKW
#undef ATT_PAF
#undef ATT_VFR
#undef ATT_VRD
#undef ATT_KRD
#undef ATT_GAPA
#undef ATT_GAPB
#undef ATT_STEP
#undef ATT_ENDW
}
#undef ATT_WAIT_BAR
}
#ifndef PROBE_DUP
#define PROBE_DUP -1
#endif
namespace gdn {
typedef __attribute__((ext_vector_type(8))) short bf16x8;
typedef __attribute__((ext_vector_type(16))) float f32x16;
typedef __attribute__((ext_vector_type(4))) unsigned u32x4;
typedef __attribute__((ext_vector_type(4))) float f32x4;
#define GLAS __attribute__((address_space(3)))
constexpr int UNIT_BYTES = 74752, OFF_W = 0, OFF_Q = 16384, OFF_KT = 32768, OFF_P = 49152, OFF_U = 57344, OFF_SC = 73728, DMA_BYTES = 57344;
constexpr int L_KN = 0, L_QN = 17408, L_VBT = 34816, L_KBGT = 53248, L_A = 71680, L_T = 89088, L_SC = 98304, L_A10B = 99328, L_T00T = 101888, L_RAW = 104448, RAW_ARR = 17408, L_CW = L_RAW + 3 * RAW_ARR, L_END = L_CW + 6144, L_PRE = 163328;
constexpr int A10P = 40;
constexpr int KNP = 136, VTP = 72, AP = 68, TP = 72;
__device__ __forceinline__ int crow(int r, int hi) { return (r & 3) + 8 * (r >> 2) + 4 * hi; }
__device__ __forceinline__ unsigned cvtpk(float lo, float hi) { typedef float f2 __attribute__((ext_vector_type(2))); typedef __bf16 b2 __attribute__((ext_vector_type(2))); f2 v = {lo, hi}; b2 b = __builtin_convertvector(v, b2); return __builtin_bit_cast(unsigned, b); }
__device__ __forceinline__ bf16x8 pack8(const f32x16& x, int o) { u32x4 w = {cvtpk(x[o], x[o + 1]), cvtpk(x[o + 2], x[o + 3]), cvtpk(x[o + 4], x[o + 5]), cvtpk(x[o + 6], x[o + 7])}; return __builtin_bit_cast(bf16x8, w); }
__device__ __forceinline__ float b2f(unsigned short b) { return __builtin_bit_cast(float, (unsigned)b << 16); }
__device__ __forceinline__ void glds16(const void* gsrc, unsigned lds_dst) { unsigned keep;
    asm volatile("s_mov_b32 %0, m0\n\ts_mov_b32 m0, %2\n\ts_nop 0\n\tglobal_load_lds_dwordx4 %1, off\n\ts_mov_b32 m0, %0" : "=&s"(keep) : "v"(gsrc), "s"(lds_dst) : "memory"); }

__device__ __forceinline__ void glds4(const void* gsrc, unsigned lds_dst) { unsigned keep;
    asm volatile("s_mov_b32 %0, m0\n\ts_mov_b32 m0, %2\n\ts_nop 0\n\tglobal_load_lds_dword %1, off\n\ts_mov_b32 m0, %0" : "=&s"(keep) : "v"(gsrc), "s"(lds_dst) : "memory"); }
__device__ __forceinline__ void prep_issue_raw(int u, const unsigned short* GQ, const unsigned short* GK, const unsigned short* GV, char* shm, int tid) {
    const int lane = tid & 63, wave = __builtin_amdgcn_readfirstlane(tid >> 6);
    const int bh = u >> 7, n = u & 127, b = bh >> 2, h = bh & 3; const long m0 = (long)b * 8192 + n * 64;
    const unsigned lds0 = (unsigned)(uintptr_t)shm + L_RAW;
#pragma unroll
    for (int x = 0; x < 7; ++x) { const int piece = wave + 8 * x;
        if (piece < 51) { const int arr = piece / 17, p = piece % 17; const unsigned short* src = (arr == 0 ? GQ : (arr == 1 ? GK : GV)) + (m0 - 3 + 4 * p + (lane >> 4)) * 512 + h * 128 + 8 * (lane & 15);
            glds16(src, (unsigned)__builtin_amdgcn_readfirstlane(lds0 + arr * RAW_ARR + p * 1024)); } }
}
__device__ __forceinline__ void prep_issue_pre(int u, const float* beta, const float* loga, char* shm, int tid) {
    const int lane = tid & 63, wave = __builtin_amdgcn_readfirstlane(tid >> 6);
    const int bh = u >> 7, n = u & 127, b = bh >> 2, h = bh & 3; const long m0 = (long)b * 8192 + n * 64;
    if (wave == 7) { glds4(beta + (m0 + lane) * 4 + h, (unsigned)__builtin_amdgcn_readfirstlane((unsigned)(uintptr_t)shm + L_PRE)); glds4(loga + (m0 + lane) * 4 + h, (unsigned)__builtin_amdgcn_readfirstlane((unsigned)(uintptr_t)shm + L_PRE + 256)); }
}
__device__ __forceinline__ void prep_unit(int u, const unsigned short* GQ, const unsigned short* GK, const unsigned short* GV, const float* beta, const float* loga, const float* cw, unsigned char* ops, char* shm, int tid_in, int u_next) {
    int tid_ = tid_in; asm volatile("" : "+v"(tid_));
    const int tid = tid_, lane = tid & 63, wave = __builtin_amdgcn_readfirstlane(tid >> 6), r32 = lane & 31, hi = lane >> 5;
    const int bh = u >> 7, n = u & 127, b = bh >> 2, h = bh & 3, t0 = n * 64; const long m0 = (long)b * 8192 + t0;
    unsigned char* ub = ops + (size_t)u * UNIT_BYTES;
    GLAS unsigned short* Kn = (GLAS unsigned short*)(shm + L_KN); GLAS unsigned short* Qn = (GLAS unsigned short*)(shm + L_QN);
    GLAS unsigned short* VBt = (GLAS unsigned short*)(shm + L_VBT); GLAS unsigned short* KBGt = (GLAS unsigned short*)(shm + L_KBGT);
    GLAS float* Am = (GLAS float*)(shm + L_A); GLAS unsigned short* Tb = (GLAS unsigned short*)(shm + L_T);
    GLAS float* sc_g = (GLAS float*)(shm + L_SC); GLAS float* sc_beta = sc_g + 64; GLAS float* sc_eg = sc_g + 128; GLAS float* sc_ekl = sc_g + 192;
    GLAS unsigned short* A10b = (GLAS unsigned short*)(shm + L_A10B); GLAS unsigned short* T00t = (GLAS unsigned short*)(shm + L_T00T);
    asm volatile("s_waitcnt vmcnt(0)" ::: "memory"); __syncthreads();
    for (int rep0_ = 0; rep0_ < (PROBE_DUP == 205 ? 2 : 1); ++rep0_)
    if (wave == 0) {
        const float bt = beta[(m0 + lane) * 4 + h]; float g = loga[(m0 + lane) * 4 + h];
#pragma unroll
        for (int o = 1; o < 64; o <<= 1) { const float x = __builtin_bit_cast(float, __builtin_amdgcn_ds_bpermute((lane - o) << 2, __builtin_bit_cast(int, g))); if (lane >= o) g += x; }
        const float gl = __builtin_bit_cast(float, __builtin_amdgcn_readlane(__builtin_bit_cast(int, g), 63));
        sc_g[lane] = g; sc_beta[lane] = bt; sc_eg[lane] = __expf(g); sc_ekl[lane] = __expf(gl - g);
        if (lane == 63) *(float*)(ub + OFF_SC) = __expf(g);
    }
    const int tok = tid >> 3, part = tid & 7, c0 = h * 128 + 16 * part;
    float q[16], k[16], v[16];
#pragma unroll
    for (int c = 0; c < 16; ++c) { q[c] = 0.f; k[c] = 0.f; v[c] = 0.f; }
    {
        const GLAS unsigned short* rawq = (const GLAS unsigned short*)(shm + L_RAW) + tok * 128 + 16 * part;
#pragma unroll
        for (int j = 0; j < 4; ++j) {
            const bool ok = t0 + tok - 3 + j >= 0;
            const u32x4 q0 = *(const GLAS u32x4*)(rawq + j * 128), q1 = *(const GLAS u32x4*)(rawq + j * 128 + 8);
            const u32x4 k0 = *(const GLAS u32x4*)(rawq + RAW_ARR / 2 + j * 128), k1 = *(const GLAS u32x4*)(rawq + RAW_ARR / 2 + j * 128 + 8);
            const u32x4 v0 = *(const GLAS u32x4*)(rawq + RAW_ARR + j * 128), v1 = *(const GLAS u32x4*)(rawq + RAW_ARR + j * 128 + 8);
            const GLAS float* wq = (const GLAS float*)(shm + L_CW) + j * 384 + 16 * part; const GLAS float* wk = wq + 128; const GLAS float* wv = wq + 256;
#pragma unroll
            for (int c4 = 0; c4 < 4; ++c4) {
                const f32x4 wq4 = *(const GLAS f32x4*)(wq + 4 * c4), wk4 = *(const GLAS f32x4*)(wk + 4 * c4), wv4 = *(const GLAS f32x4*)(wv + 4 * c4);
#pragma unroll
                for (int e = 0; e < 4; ++e) { const int c = 4 * c4 + e;
                    unsigned qw = c < 8 ? q0[c >> 1] : q1[(c - 8) >> 1], kw = c < 8 ? k0[c >> 1] : k1[(c - 8) >> 1], vw = c < 8 ? v0[c >> 1] : v1[(c - 8) >> 1];
                    qw = ok ? qw : 0u; kw = ok ? kw : 0u; vw = ok ? vw : 0u;
                    const float qv = __builtin_bit_cast(float, (c & 1) ? (qw & 0xffff0000u) : (qw << 16)), kv = __builtin_bit_cast(float, (c & 1) ? (kw & 0xffff0000u) : (kw << 16)), vv = __builtin_bit_cast(float, (c & 1) ? (vw & 0xffff0000u) : (vw << 16));
                    q[c] += wq4[e] * qv; k[c] += wk4[e] * kv; v[c] += wv4[e] * vv; }
            }
        }
    }
    float sq = 0.f, sk = 0.f;
#pragma unroll
    for (int c = 0; c < 16; ++c) { q[c] = q[c] * __builtin_amdgcn_rcpf(1.f + __expf(-q[c])); k[c] = k[c] * __builtin_amdgcn_rcpf(1.f + __expf(-k[c])); v[c] = v[c] * __builtin_amdgcn_rcpf(1.f + __expf(-v[c])); sq += q[c] * q[c]; sk += k[c] * k[c]; }
#pragma unroll
    for (int o = 1; o < 8; o <<= 1) { sq += __builtin_bit_cast(float, __builtin_amdgcn_ds_bpermute((lane ^ o) << 2, __builtin_bit_cast(int, sq))); sk += __builtin_bit_cast(float, __builtin_amdgcn_ds_bpermute((lane ^ o) << 2, __builtin_bit_cast(int, sk))); }
    __syncthreads();
    if (u_next >= 0) prep_issue_raw(u_next, GQ, GK, GV, shm, tid);
    {
        const float rq = rsqrtf(sq + 1e-6f) * 0.08838834764831845f, rk = rsqrtf(sk + 1e-6f), bt = sc_beta[tok], eg = sc_eg[tok];
        u32x4 w0, w1;
        w0 = (u32x4){cvtpk(k[0] * rk, k[1] * rk), cvtpk(k[2] * rk, k[3] * rk), cvtpk(k[4] * rk, k[5] * rk), cvtpk(k[6] * rk, k[7] * rk)};
        w1 = (u32x4){cvtpk(k[8] * rk, k[9] * rk), cvtpk(k[10] * rk, k[11] * rk), cvtpk(k[12] * rk, k[13] * rk), cvtpk(k[14] * rk, k[15] * rk)};
        *(GLAS u32x4*)(Kn + tok * KNP + 16 * part) = w0; *(GLAS u32x4*)(Kn + tok * KNP + 16 * part + 8) = w1;
        w0 = (u32x4){cvtpk(q[0] * rq, q[1] * rq), cvtpk(q[2] * rq, q[3] * rq), cvtpk(q[4] * rq, q[5] * rq), cvtpk(q[6] * rq, q[7] * rq)};
        w1 = (u32x4){cvtpk(q[8] * rq, q[9] * rq), cvtpk(q[10] * rq, q[11] * rq), cvtpk(q[12] * rq, q[13] * rq), cvtpk(q[14] * rq, q[15] * rq)};
        *(GLAS u32x4*)(Qn + tok * KNP + 16 * part) = w0; *(GLAS u32x4*)(Qn + tok * KNP + 16 * part + 8) = w1;
        const int ptok = tok ^ (8 * part);
#pragma unroll
        for (int c = 0; c < 16; ++c) { VBt[(16 * part + c) * VTP + ptok] = (unsigned short)(cvtpk(v[c] * bt, 0.f) & 0xffffu); KBGt[(16 * part + c) * VTP + ptok] = (unsigned short)(cvtpk(k[c] * rk * bt * eg, 0.f) & 0xffffu); }
        const float qs = rq * eg; const int f = (((tok >> 5) * 4 + (part >> 1)) * 2 + (part & 1));
        const u32x4 f0 = {cvtpk(q[0] * qs, q[1] * qs), cvtpk(q[2] * qs, q[3] * qs), cvtpk(q[8] * qs, q[9] * qs), cvtpk(q[10] * qs, q[11] * qs)};
        const u32x4 f1 = {cvtpk(q[4] * qs, q[5] * qs), cvtpk(q[6] * qs, q[7] * qs), cvtpk(q[12] * qs, q[13] * qs), cvtpk(q[14] * qs, q[15] * qs)};
        *(u32x4*)(ub + OFF_Q + f * 1024 + (tok & 31) * 16) = f0; *(u32x4*)(ub + OFF_Q + f * 1024 + ((tok & 31) + 32) * 16) = f1;
    }
    __syncthreads();
    {
        const int bw = wave & 3, ba = bw >> 1, bb = bw & 1;
        const bool isP = wave >= 4;
        const bool skip = isP ? (ba == 1 && bb == 0) : (ba == 0 && bb == 1);
        if (!skip) {
            const GLAS unsigned short* Ar = Kn + (32 * ba + r32) * KNP + 8 * hi; const GLAS unsigned short* Br = (isP ? Qn : Kn) + (32 * bb + r32) * KNP + 8 * hi;
            f32x16 acc = f32x16{};
#pragma unroll
            for (int s = 0; s < 8; ++s) acc = __builtin_amdgcn_mfma_f32_32x32x16_bf16(*(const GLAS bf16x8*)(Ar + 16 * s), *(const GLAS bf16x8*)(Br + 16 * s), acc, 0, 0, 0);
            const int col = 32 * bb + r32; const float gcol = sc_g[col];
            if (!isP) {
#pragma unroll
                for (int r = 0; r < 16; ++r) { const int i = 32 * ba + crow(r, hi); const float av = i > col ? sc_beta[i] * acc[r] * __expf(sc_g[i] - gcol) : 0.f; Am[i * AP + col] = av;
                    if (ba == 1 && bb == 0) A10b[crow(r, hi) * A10P + col] = (unsigned short)(cvtpk(av, 0.f) & 0xffffu); }
            } else {
#pragma unroll
                for (int r = 0; r < 16; ++r) { const int j = 32 * ba + crow(r, hi); acc[r] = col >= j ? acc[r] * __expf(gcol - sc_g[j]) : 0.f; }
                const int fb = (bb * 2 + ba) * 2;
                *(bf16x8*)(ub + OFF_P + fb * 1024 + lane * 16) = pack8(acc, 0); *(bf16x8*)(ub + OFF_P + (fb + 1) * 1024 + lane * 16) = pack8(acc, 8);
            }
        }
#pragma unroll
        for (int x = 0; x < 2; ++x) {
            const int item = tid + 512 * x, f = item >> 6, ln = item & 63, dk = 32 * (f >> 2) + (ln & 31), jb0 = 32 * ((f >> 1) & 1) + 16 * (f & 1) + 4 * (ln >> 5);
            float e[8];
#pragma unroll
            for (int j = 0; j < 8; ++j) { const int tk = jb0 + (j & 3) + 8 * (j >> 2); e[j] = b2f(Kn[tk * KNP + dk]) * sc_ekl[tk]; }
            const u32x4 w = {cvtpk(e[0], e[1]), cvtpk(e[2], e[3]), cvtpk(e[4], e[5]), cvtpk(e[6], e[7])};
            *(u32x4*)(ub + OFF_KT + f * 1024 + ln * 16) = w;
        }
    }
    __syncthreads();
    for (int rep3_ = 0; rep3_ < (PROBE_DUP == 203 ? 2 : 1); ++rep3_) {
    if (wave == 0) {
        const int blk = hi, c = r32; const GLAS float* Ab = Am + (32 * blk) * AP + 32 * blk;
        float Tc[32];
#pragma unroll
        for (int i = 0; i < 32; ++i) {
            float s0 = (i == c) ? 1.f : 0.f, s1 = 0.f, s2 = 0.f, s3 = 0.f;
#pragma unroll
            for (int j4 = 0; j4 < (i + 3) / 4; ++j4) { const f32x4 a4 = *(const GLAS f32x4*)(Ab + i * AP + 4 * j4);
                if (4 * j4 + 0 < i) s0 -= a4[0] * Tc[4 * j4 + 0]; if (4 * j4 + 1 < i) s1 -= a4[1] * Tc[4 * j4 + 1]; if (4 * j4 + 2 < i) s2 -= a4[2] * Tc[4 * j4 + 2]; if (4 * j4 + 3 < i) s3 -= a4[3] * Tc[4 * j4 + 3]; }
            Tc[i] = (s0 + s1) + (s2 + s3);
            Tb[(32 * blk + i) * TP + 32 * blk + c] = (unsigned short)(cvtpk(Tc[i], 0.f) & 0xffffu);
            if (blk == 1) Tb[i * TP + 32 + c] = 0;
        }
        if (blk == 0) {
#pragma unroll
            for (int x = 0; x < 4; ++x) { const u32x4 w = {cvtpk(Tc[8 * x], Tc[8 * x + 1]), cvtpk(Tc[8 * x + 2], Tc[8 * x + 3]), cvtpk(Tc[8 * x + 4], Tc[8 * x + 5]), cvtpk(Tc[8 * x + 6], Tc[8 * x + 7])}; *(GLAS u32x4*)(T00t + c * A10P + 8 * x) = w; }
        }
        asm volatile("s_waitcnt lgkmcnt(0)" ::: "memory");
        f32x16 X = f32x16{};
#pragma unroll
        for (int s = 0; s < 2; ++s) X = __builtin_amdgcn_mfma_f32_32x32x16_bf16(*(const GLAS bf16x8*)(A10b + r32 * A10P + 16 * s + 8 * hi), *(const GLAS bf16x8*)(T00t + r32 * A10P + 16 * s + 8 * hi), X, 0, 0, 0);
        f32x16 Y = f32x16{};
#pragma unroll
        for (int s = 0; s < 2; ++s) {
            typedef __attribute__((ext_vector_type(2))) unsigned u32x2;
            const GLAS unsigned short* tr = Tb + (32 + r32) * TP + 32 + 16 * s + 4 * hi;
            const u32x2 lo2 = *(const GLAS u32x2*)tr, hi2 = *(const GLAS u32x2*)(tr + 8);
            const u32x4 aw = {lo2[0], lo2[1], hi2[0], hi2[1]};
            Y = __builtin_amdgcn_mfma_f32_32x32x16_bf16(__builtin_bit_cast(bf16x8, aw), pack8(X, 8 * s), Y, 0, 0, 0); }
#pragma unroll
        for (int r = 0; r < 16; ++r) Tb[(32 + crow(r, hi)) * TP + r32] = (unsigned short)(cvtpk(-Y[r], 0.f) & 0xffffu);
    }
    __syncthreads();
    }
    {
        const int ib = wave >> 2, dvb = wave & 3;
        const GLAS unsigned short* Ar = Tb + (32 * ib + r32) * TP + 8 * hi; const GLAS unsigned short* Br = VBt + (32 * dvb + r32) * VTP; const int px = (2 * dvb + (r32 >> 4)) & 7;
        f32x16 acc = f32x16{};
#pragma unroll
        for (int s = 0; s < 4; ++s) acc = __builtin_amdgcn_mfma_f32_32x32x16_bf16(*(const GLAS bf16x8*)(Ar + 16 * s), *(const GLAS bf16x8*)(Br + 8 * ((2 * s + hi) ^ px)), acc, 0, 0, 0);
        unsigned char* up = ub + OFF_U + (ib * 4 + dvb) * 2048 + lane * 32;
        *(bf16x8*)up = pack8(acc, 0); *(bf16x8*)(up + 16) = pack8(acc, 8);
    }
    {
        const int dkb = wave >> 1, ib = wave & 1;
        const GLAS unsigned short* Ar = KBGt + (32 * dkb + r32) * VTP; const int px = (2 * dkb + (r32 >> 4)) & 7; const GLAS unsigned short* Br = Tb + (32 * ib + r32) * TP + 8 * hi;
        f32x16 acc = f32x16{};
#pragma unroll
        for (int s = 0; s < 4; ++s) acc = __builtin_amdgcn_mfma_f32_32x32x16_bf16(*(const GLAS bf16x8*)(Ar + 8 * ((2 * s + hi) ^ px)), *(const GLAS bf16x8*)(Br + 16 * s), acc, 0, 0, 0);
#pragma unroll
        for (int r = 0; r < 16; ++r) acc[r] = -acc[r];
        const int fb = (ib * 4 + dkb) * 2;
        *(bf16x8*)(ub + OFF_W + fb * 1024 + lane * 16) = pack8(acc, 0); *(bf16x8*)(ub + OFF_W + (fb + 1) * 1024 + lane * 16) = pack8(acc, 8);
    }
    __syncthreads();
}

constexpr int OBUF_OFF = 2 * DMA_BYTES, OBP = 136, OBUF_BYTES = 64 * OBP * 2, SCAN_LDS = OBUF_OFF + 2 * OBUF_BYTES;
template <int MODE>
__device__ __forceinline__ void scan_bh(int bh, const unsigned char* ops, const unsigned short* GG, unsigned short* CAT, char* shm, int tid_in) {
    int tid_ = tid_in; asm volatile("" : "+v"(tid_));
    const int tid = tid_, lane = tid & 63, wave = __builtin_amdgcn_readfirstlane(tid >> 6), r32 = lane & 31, hi = lane >> 5;
    const int b = bh >> 2, h = bh & 3;
    const unsigned lds0 = (unsigned)(uintptr_t)shm;
    const unsigned char* ub0 = ops + (size_t)(bh * 128) * UNIT_BYTES;
#define GDN_DMA(n, bufi) do { const unsigned char* src_ = ub0 + (size_t)(n) * UNIT_BYTES + wave * 1024 + lane * 16; const unsigned dst_ = lds0 + (bufi) * DMA_BYTES + wave * 1024; \
        _Pragma("unroll") for (int x_ = 0; x_ < 7; ++x_) glds16(src_ + x_ * 8192, (unsigned)__builtin_amdgcn_readfirstlane(dst_ + x_ * 8192)); } while (0)
#define GDN_DMA14(n, bufi) do { const unsigned char* src_ = ub0 + (size_t)(n) * UNIT_BYTES + (wave & 3) * 1024 + lane * 16; const unsigned dst_ = lds0 + (bufi) * DMA_BYTES + (wave & 3) * 1024; \
        _Pragma("unroll") for (int x_ = 0; x_ < 14; ++x_) glds16(src_ + x_ * 4096, (unsigned)__builtin_amdgcn_readfirstlane(dst_ + x_ * 4096)); } while (0)
    const int ptk = 16 * (wave & 3) + (lane >> 2), pcol = 32 * (lane & 3);
    const unsigned short* gg0 = GG + ((size_t)b * 8192) * 512 + h * 128; unsigned short* cat0 = CAT + ((size_t)b * 8192) * 1024 + h * 128;
    f32x16 St[4];
#pragma unroll
    for (int d = 0; d < 4; ++d) St[d] = f32x16{};
    u32x4 uraw[2][2] = {}; float gl = 0.f;
    GDN_DMA(0, 0);
    if (wave < 4) {
#pragma unroll
        for (int ib = 0; ib < 2; ++ib) { const unsigned char* up = ub0 + OFF_U + (ib * 4 + wave) * 2048 + lane * 32; uraw[ib][0] = *(const u32x4*)up; uraw[ib][1] = *(const u32x4*)(up + 16); }
        gl = *(const float*)(ub0 + OFF_SC);
    }
    for (int n = 0; n <= 128; ++n) {
        asm volatile("s_waitcnt vmcnt(0) lgkmcnt(0)\n\ts_barrier" ::: "memory");
        if (wave < 4) {
            if (n == 128) break;
            if (MODE & 8) continue;
            const GLAS char* buf = (const GLAS char*)(shm) + (n & 1) * DMA_BYTES + lane * 16;
            const float glc = gl;
            f32x16 vacc[2], oacc[2];
#pragma unroll
            for (int ib = 0; ib < 2; ++ib) { oacc[ib] = f32x16{};
#pragma unroll
                for (int r = 0; r < 16; ++r) { const unsigned w = uraw[ib][r >> 3][(r & 7) >> 1]; vacc[ib][r] = __builtin_bit_cast(float, (r & 1) ? (w & 0xffff0000u) : (w << 16)); } }
            asm volatile("" : "+v"(vacc[0]), "+v"(vacc[1]));
            if (n + 1 < 128) { const unsigned char* ubn = ub0 + (size_t)(n + 1) * UNIT_BYTES;
#pragma unroll
                for (int ib = 0; ib < 2; ++ib) { const unsigned char* up = ubn + OFF_U + (ib * 4 + wave) * 2048 + lane * 32; uraw[ib][0] = *(const u32x4*)up; uraw[ib][1] = *(const u32x4*)(up + 16); }
                gl = *(const float*)(ubn + OFF_SC); }
            constexpr int SCAN_PF = 6;
            bf16x8 fr[SCAN_PF];
#define GDN_FOFF(i) ((i) < 32 ? (((i) & 1) ? OFF_Q : OFF_W) + ((i) >> 1) * 1024 \
                   : (i) < 48 ? OFF_KT + (((((i) - 32) & 3) * 2 + ((((i) - 32) >> 2) >> 1)) * 2 + ((((i) - 32) >> 2) & 1)) * 1024 \
                   : OFF_P + ((((i) - 48) % 3 == 0 ? 0 : ((i) - 48) % 3 == 1 ? 2 : 3) * 2 + ((i) - 48) / 3) * 1024)
#pragma unroll
            for (int j = 0; j < SCAN_PF; ++j) fr[j] = *(const GLAS bf16x8*)(buf + GDN_FOFF(j));
            bf16x8 Sb[4][2];
#pragma unroll
            for (int d = 0; d < 4; ++d) { Sb[d][0] = pack8(St[d], 0); Sb[d][1] = pack8(St[d], 8); }
            bf16x8 vb[2][2];
            __builtin_amdgcn_sched_barrier(0);
#pragma clang loop unroll(full)
            for (int i = 0; i < 54; ++i) {
                const bf16x8 af = fr[i % SCAN_PF];
                if (i + SCAN_PF < 54) fr[i % SCAN_PF] = *(const GLAS bf16x8*)(buf + GDN_FOFF(i + SCAN_PF));
                if (i < 32) { const int f = i >> 1, ib = f >> 3, d = (f >> 1) & 3, sx = f & 1;
                    if (i & 1) oacc[ib] = __builtin_amdgcn_mfma_f32_32x32x16_bf16(af, Sb[d][sx], oacc[ib], 0, 0, 0); else vacc[ib] = __builtin_amdgcn_mfma_f32_32x32x16_bf16(af, Sb[d][sx], vacc[ib], 0, 0, 0);
                    St[i >> 3][(i & 7) * 2] *= glc; St[i >> 3][(i & 7) * 2 + 1] *= glc;
                } else if (i < 48) {
                    if (i == 32) {
#pragma unroll
                        for (int ib = 0; ib < 2; ++ib) { vb[ib][0] = pack8(vacc[ib], 0); vb[ib][1] = pack8(vacc[ib], 8); } }
                    const int k = i - 32, d = k & 3, jb = (k >> 2) >> 1, sx = (k >> 2) & 1;
                    St[d] = __builtin_amdgcn_mfma_f32_32x32x16_bf16(af, vb[jb][sx], St[d], 0, 0, 0);
                } else { const int k = i - 48, w = k % 3, sx = k / 3;
                    if (w == 0) oacc[0] = __builtin_amdgcn_mfma_f32_32x32x16_bf16(af, vb[0][sx], oacc[0], 0, 0, 0);
                    else if (w == 1) oacc[1] = __builtin_amdgcn_mfma_f32_32x32x16_bf16(af, vb[0][sx], oacc[1], 0, 0, 0);
                    else oacc[1] = __builtin_amdgcn_mfma_f32_32x32x16_bf16(af, vb[1][sx], oacc[1], 0, 0, 0); }
                __builtin_amdgcn_sched_barrier(0);
            }
#undef GDN_FOFF
            GLAS unsigned short* ob = (GLAS unsigned short*)(shm + OBUF_OFF + (n & 1) * OBUF_BYTES) + 32 * wave + r32;
#pragma unroll
            for (int ib = 0; ib < 2; ++ib)
#pragma unroll
                for (int r = 0; r < 16; ++r) ob[(32 * ib + crow(r, hi)) * OBP] = (unsigned short)(cvtpk(oacc[ib][r], 0.f) & 0xffffu);
        } else {
            if (!(MODE & 4) && n + 1 < 128) GDN_DMA14(n + 1, (n + 1) & 1);
            if (n > 0 && !(MODE & 2)) {
                const GLAS unsigned short* ob = (const GLAS unsigned short*)(shm + OBUF_OFF + ((n - 1) & 1) * OBUF_BYTES) + ptk * OBP + pcol;
                u32x4 xr[4];
#pragma unroll
                for (int i = 0; i < 4; ++i) xr[i] = *(const GLAS u32x4*)(ob + 8 * i);
                float x[32]; float ss = 0.f;
#pragma unroll
                for (int i = 0; i < 32; ++i) { const unsigned w = xr[i >> 3][(i & 7) >> 1]; x[i] = __builtin_bit_cast(float, (i & 1) ? (w & 0xffff0000u) : (w << 16)); ss += x[i] * x[i]; }
                ss += __builtin_bit_cast(float, __builtin_amdgcn_ds_bpermute((lane ^ 1) << 2, __builtin_bit_cast(int, ss)));
                ss += __builtin_bit_cast(float, __builtin_amdgcn_ds_bpermute((lane ^ 2) << 2, __builtin_bit_cast(int, ss)));
                const float rs = rsqrtf(ss * (1.f / 128.f) + 1e-6f);
                unsigned short* op = cat0 + (size_t)((n - 1) * 64) * 1024 + ptk * 1024 + pcol;
#pragma unroll
                for (int i4 = 0; i4 < 4; ++i4) { u32x4 o;
#pragma unroll
                    for (int e = 0; e < 4; ++e) { const unsigned g = uraw[i4 >> 1][i4 & 1][e];
                        o[e] = cvtpk(x[8 * i4 + 2 * e] * rs * __builtin_bit_cast(float, g << 16), x[8 * i4 + 2 * e + 1] * rs * __builtin_bit_cast(float, g & 0xffff0000u)); }
                    if (!(MODE & 1)) *(u32x4*)(op + 8 * i4) = o; else asm volatile("" :: "v"(o)); }
            }
            if (n == 128) break;
            { const unsigned short* gp = gg0 + (size_t)(n * 64) * 512 + ptk * 512 + pcol;
#pragma unroll
              for (int i = 0; i < 4; ++i) uraw[i >> 1][i & 1] = *(const u32x4*)(gp + 8 * i); }
        }
    }
    asm volatile("s_waitcnt vmcnt(0) lgkmcnt(0)\n\ts_barrier" ::: "memory");
#undef GDN_DMA
#undef GDN_DMA14
}
#undef GLAS
}
__device__ __forceinline__ bf16* wsb(const Args& a, size_t off) { return (bf16*)(a.ws + off); }
__device__ __forceinline__ float* wsf(const Args& a, size_t off) { return (float*)(a.ws + off); }

__device__ __forceinline__ void p0_prologue(const Args& a, Frame& F) {
    LAS float* scr = (LAS float*)(F.lds + RING_OFF + F.wave * 16384);
    constexpr int I_IN = 16 * 80, I_Q = 4 * 24, I_KV = 2 * 32, I_O = 16 * 32, I_UP = 16 * 128, I_DN = 64 * 32, PER = I_IN + I_Q + I_KV + I_O + I_UP + I_DN;
    for (int repa_ = 0; repa_ < (PROBE_DUP == 501 ? 2 : 1); ++repa_)
    for (int it = F.gw; it < 2 * PER; it += F.NGW) {
        const int l = it / PER; int r = it % PER;
        if (r < I_IN) { p0_transpose_item(a.w_in + (size_t)l * 1024 * IN_W, 1024, IN_W, 80, wsb(a, WS_WIN + l * 5 * MiB), nullptr, 0, 0, scr, r, F.lane, MapWin()); continue; } r -= I_IN;
        if (r < I_Q) { p0_transpose_item(a.w_q_up + (size_t)l * 256 * 768, 256, 768, 24, wsb(a, WS_WQ + l * 384 * KiB), a.q_norm + l * 256, 256, 255, scr, r, F.lane, MapId()); continue; } r -= I_Q;
        if (r < I_KV) { p0_transpose_item(a.w_kv_up + (size_t)l * 128 * 1024, 128, 1024, 32, wsb(a, WS_WKV + l * 256 * KiB), a.kv_norm + l * 128, 128, 127, scr, r, F.lane, MapId()); continue; } r -= I_KV;
        if (r < I_O) { p0_transpose_item(a.w_out + (size_t)l * 1024 * 1024, 1024, 1024, 32, wsb(a, WS_WOUT + l * 2 * MiB), a.gdn_norm + l * 128, 512, 127, scr, r, F.lane, MapId()); continue; } r -= I_O;
        if (r < I_UP) { p0_transpose_item(a.w_up + (size_t)l * 1024 * FF, 1024, FF, 128, wsb(a, WS_WUP + l * 8 * MiB), nullptr, 0, 0, scr, r, F.lane, MapId()); continue; } r -= I_UP;
        p0_transpose_item(a.w_down + (size_t)l * FF * 1024, FF, 1024, 32, wsb(a, WS_WDN + l * 8 * MiB), nullptr, 0, 0, scr, r, F.lane, MapId());
    }
    float* ct = wsf(a, WS_COS); float* sn = wsf(a, WS_SIN);
    for (int i = F.gw * 64 + F.lane; i < M * 16; i += F.NGW * 64) {
        const int m = i >> 4, j = i & 15;
        const float inv = __builtin_amdgcn_exp2f(-(float)j * 0.8304820237218406f);
        const float ang = (float)a.pos[m] * inv;
        ct[i] = cosf(ang); sn[i] = sinf(ang);
    }
    for (int repb_ = 0; repb_ < (PROBE_DUP == 502 ? 2 : 1); ++repb_)
    for (int m = F.gw; m < M; m += 4 * F.NGW) rms_rows_to_bf16<4>(F.lane, a.x + (size_t)m * D, (size_t)F.NGW * D, a.mix_pre, wsb(a, WS_XN) + (size_t)m * D);
}

constexpr float QSCALE = 0.10206207261596577f * 1.4426950408889634f;
__device__ __forceinline__ void mla_side(const Args& a, Frame& F, int l) {
    const bf16* REST = wsb(a, WS_REST);
    float* beta = wsf(a, WS_BETA); float* loga = wsf(a, WS_LOGA);
    for (int i = F.gw * 64 + F.lane; i < M * 4; i += F.NGW * 64) {
        const int m = i >> 2, h = i & 3;
        const float bl = bf2f(REST[(size_t)m * 512 + R_GB + h]), al = bf2f(REST[(size_t)m * 512 + R_GA + h]) + a.dt_bias[l * 4 + h];
        beta[i] = 1.f / (1.f + __expf(-bl));
        const float sp = fmaxf(al, 0.f) + __logf(1.f + __expf(-fabsf(al)));
        loga[i] = -__expf(a.a_log[l * 4 + h]) * sp;
    }
    bf16* K = wsb(a, WS_K); const float* ct = wsf(a, WS_COS); const float* sn = wsf(a, WS_SIN);
    for (int m4 = F.gw * 4; m4 < M; m4 += F.NGW * 4) {
        const int m = m4 + (F.lane >> 4), h = F.lane & 7, hf = (F.lane >> 3) & 1;
        const bf16* kr = REST + (size_t)m * 512 + R_KR;
        const v4u k0 = *(const v4u*)kr, k1 = *(const v4u*)(kr + 8), k2 = *(const v4u*)(kr + 16), k3 = *(const v4u*)(kr + 24);
        const f32x4* cp = (const f32x4*)(ct + (size_t)m * 16); const f32x4* sp = (const f32x4*)(sn + (size_t)m * 16);
        float o[16];
#pragma unroll
        for (int q4 = 0; q4 < 4; ++q4) { const f32x4 c4 = cp[q4], s4 = sp[q4];
#pragma unroll
            for (int e = 0; e < 4; ++e) { const int j = 4 * q4 + e;
                const unsigned w1 = j < 8 ? k0[j >> 1] : k1[(j - 8) >> 1], w2 = j < 8 ? k2[j >> 1] : k3[(j - 8) >> 1];
                const float x1 = __builtin_bit_cast(float, (j & 1) ? (w1 & 0xffff0000u) : (w1 << 16)), x2 = __builtin_bit_cast(float, (j & 1) ? (w2 & 0xffff0000u) : (w2 << 16));
                o[j] = hf == 0 ? x1 * c4[e] - x2 * s4[e] : x2 * c4[e] + x1 * s4[e]; } }
        v4u oa, ob;
#pragma unroll
        for (int i = 0; i < 4; ++i) { oa[i] = pk2(o[2 * i], o[2 * i + 1]); ob[i] = pk2(o[8 + 2 * i], o[9 + 2 * i]); }
        bf16* kp = K + (size_t)m * 768 + h * 96 + 64 + 16 * hf;
        *(v4u*)kp = oa; *(v4u*)(kp + 8) = ob;
    }
}
template <int NCOL>
__device__ __forceinline__ void norm_panel(Frame& F, const bf16* REST, int coff, float scale, bf16* dst, int row0) {
    constexpr int LPR = NCOL / 16, RPW = 64 / LPR;
    const int rl = F.lane / LPR, cl = F.lane % LPR;
#pragma unroll
    for (int it = 0; it < 256 / (RPW * NWAVES); ++it) {
        const int m = row0 + (it * NWAVES + F.wave) * RPW + rl;
        const bf16* src = REST + (size_t)m * 512 + coff + 16 * cl;
        const v4u a = *(const v4u*)src, b = *(const v4u*)(src + 8);
        float v[16]; float s = 0.f;
#pragma unroll
        for (int i = 0; i < 16; ++i) { const unsigned w = i < 8 ? a[i >> 1] : b[(i - 8) >> 1]; v[i] = __builtin_bit_cast(float, (i & 1) ? (w & 0xffff0000u) : (w << 16)); s += v[i] * v[i]; }
#pragma unroll
        for (int o = 1; o < LPR; o <<= 1) s += pg8::shx(s, F.lane, o);
        const float rs = rsqrtf(s * (1.f / NCOL) + EPS) * scale;
        v4u oa, ob;
#pragma unroll
        for (int i = 0; i < 4; ++i) { oa[i] = pk2(v[2 * i] * rs, v[2 * i + 1] * rs); ob[i] = pk2(v[8 + 2 * i] * rs, v[9 + 2 * i] * rs); }
        bf16* d = dst + (size_t)m * NCOL + 16 * cl;
        *(v4u*)d = oa; *(v4u*)(d + 8) = ob;
    }
}
__device__ __forceinline__ void gdn_prep_phase(const Args& a, Frame& F, int l, char* lds) {
    const int bh = F.vcu & 7, n0 = F.vcu >> 3, nstep = F.G >> 3;
    { const float* cw = a.conv_w + (size_t)l * 4 * 1536; LAS float* cwl = (LAS float*)(lds + gdn::L_CW); const int h = bh & 3;
      for (int i = F.tid; i < 1536; i += NWAVES * 64) { const int j = i / 384, ar = (i % 384) / 128, c = i % 128; cwl[i] = cw[j * 1536 + ar * 512 + h * 128 + c]; } }
    if (n0 < 128) gdn::prep_issue_raw(bh * 128 + n0, wsb(a, WS_GQ), wsb(a, WS_GK), wsb(a, WS_GV), lds, F.tid);
    for (int n = n0; n < 128; n += nstep)
        gdn::prep_unit(bh * 128 + n, wsb(a, WS_GQ), wsb(a, WS_GK), wsb(a, WS_GV), wsf(a, WS_BETA), wsf(a, WS_LOGA), a.conv_w + (size_t)l * 4 * 1536, a.ws + WS_OPS, lds, F.tid, n + nstep < 128 ? bh * 128 + n + nstep : -1);
}
constexpr int CW_QUEUE = 8192;
#ifndef PROBE_DUP
#define PROBE_DUP -1
#endif
__device__ __forceinline__ void p3_phase(const Args& a, Frame& F, int l, char* lds, volatile LAS unsigned* MISC, int rep = 0, bool do_scan = true, bool do_attn = true) {
    constexpr int SCAN_MODE = (PROBE_DUP >= 60 && PROBE_DUP < 76) ? (PROBE_DUP - 60) : 0;
    const int per = F.G >> 3, grp = F.vcu / per;
    if (do_scan && F.vcu % per == 0) { if (rep == 0) gdn::scan_bh<0>(grp, a.ws + WS_OPS, wsb(a, WS_GG), wsb(a, WS_CAT), lds, F.tid); else gdn::scan_bh<SCAN_MODE | 1>(grp, a.ws + WS_OPS, wsb(a, WS_GG), wsb(a, WS_CAT), lds, F.tid); }
    if (do_scan && F.vcu % per == 0 && rep == 0) return;
    if (0) gdn::scan_bh<0>(grp, a.ws + WS_OPS, wsb(a, WS_GG), wsb(a, WS_CAT), lds, F.tid);
    if (!do_attn) return;
    gu32* qbase = (gu32*)(a.ws + WS_CTL) + CW_QUEUE + (l + 2 * rep) * 8 * 64;
    for (int gi = 0; gi < 8; ++gi) {
        const int g = (grp + gi) & 7;
        for (;;) {
            const int tnow = F.wave * 64 + lane_now();
            if (tnow == 0) MISC[12] = __hip_atomic_fetch_add(qbase + g * 64, 1u, RLX_AGENT);
            __syncthreads();
            const unsigned idx = MISC[12];
            __syncthreads();
            if (idx >= 64u) break;
            const int bh = 2 * g + (int)(idx & 1u), qb = 31 - (int)(idx >> 1);
            constexpr int ATT_MODE = (PROBE_DUP >= 300 && PROBE_DUP < 428) ? (PROBE_DUP - 300) : 0;
            if (rep) att::attn_unit<ATT_MODE | 1>(bh >> 3, bh & 7, qb, wsb(a, WS_Q), wsb(a, WS_K), wsb(a, WS_V), wsb(a, WS_CAT), wsf(a, WS_COS), wsf(a, WS_SIN), lds, tnow); else
            att::attn_unit<0>(bh >> 3, bh & 7, qb, wsb(a, WS_Q), wsb(a, WS_K), wsb(a, WS_V), wsb(a, WS_CAT), wsf(a, WS_COS), wsf(a, WS_SIN), lds, tnow);
        }
    }
}
__device__ __forceinline__ void gdn_post_naive(const Args& a, Frame& F, int l) {
    const bf16* ORAW = wsb(a, WS_ORAW); const bf16* GG = wsb(a, WS_GG); bf16* CAT = wsb(a, WS_CAT);
    const float* on = a.gdn_norm + l * 128;
    for (int u = F.gw; u < M * 4; u += F.NGW) {
        const int m = u >> 2, h = u & 3;
        const size_t o = (size_t)m * 512 + h * 128 + F.lane;
        const float x0 = bf2f(ORAW[o]), x1 = bf2f(ORAW[o + 64]);
        const float r = rsqrtf(wave_sum(x0 * x0 + x1 * x1, F.lane) * (1.f / 128.f) + EPS);
        CAT[(size_t)m * 1024 + h * 128 + F.lane] = (bf16)f2bf(x0 * r * on[F.lane] * silu_f(bf2f(GG[o])));
        CAT[(size_t)m * 1024 + h * 128 + F.lane + 64] = (bf16)f2bf(x1 * r * on[F.lane + 64] * silu_f(bf2f(GG[o + 64])));
    }
}

#define VGPR_FENCE() asm volatile("" ::: "v0", "v1", "v2", "v3", "v4", "v5", "v6", "v7", "v8", "v9", "v10", "v11", "v12", "v13", "v14", "v15", "v16", "v17", "v18", "v19", "v20", "v21", "v22", "v23", "v24", "v25", "v26", "v27", "v28", "v29", "v30", "v31", "v32", "v33", "v34", "v35", "v36", "v37", "v38", "v39", "v40", "v41", "v42", "v43", "v44", "v45", "v46", "v47", "v48", "v49", "v50", "v51", "v52", "v53", "v54", "v55", "v56", "v57", "v58", "v59", "v60", "v61", "v62", "v63", "v64", "v65", "v66", "v67", "v68", "v69", "v70", "v71", "v72", "v73", "v74", "v75", "v76", "v77", "v78", "v79", "v80", "v81", "v82", "v83", "v84", "v85", "v86", "v87", "v88", "v89", "v90", "v91", "v92", "v93", "v94", "v95", "v96", "v97", "v98", "v99", "v100", "v101", "v102", "v103", "v104", "v105", "v106", "v107", "v108", "v109", "v110", "v111", "v112", "v113", "v114", "v115", "v116", "v117", "v118", "v119", "v120", "v121", "v122", "v123", "v124", "v125", "v126", "v127", "v128", "v129", "v130", "v131", "v132", "v133", "v134", "v135", "v136", "v137", "v138", "v139", "v140", "v141", "v142", "v143", "v144", "v145", "v146", "v147", "v148", "v149", "v150", "v151", "v152", "v153", "v154", "v155", "v156", "v157", "v158", "v159", "v160", "v161", "v162", "v163", "v164", "v165", "v166", "v167", "v168", "v169", "v170", "v171", "v172", "v173", "v174", "v175", "v176", "v177", "v178", "v179", "v180", "v181", "v182", "v183", "v184", "v185", "v186", "v187", "v188", "v189", "v190", "v191", "v192", "v193", "v194", "v195", "v196", "v197", "v198", "v199", "v200", "v201", "v202", "v203", "v204", "v205", "v206", "v207", "v208", "v209", "v210", "v211", "v212", "v213", "v214", "v215", "v216", "v217", "v218", "v219", "v220", "v221", "v222", "v223", "v224", "v225", "v226", "v227", "v228", "v229", "v230", "v231", "v232", "v233", "v234", "v235", "v236", "v237", "v238", "v239", "v240", "v241", "v242", "v243")
__device__ __forceinline__ void frame_init(Frame& F, LAS unsigned char* ldsb) {
    F.lds = ldsb; F.lane = lane_now(); F.tid = F.wave * 64 + F.lane;
    int G = gridDim.x, bx = blockIdx.x; asm volatile("" : "+s"(G), "+s"(bx));
    F.G = G; F.vcu = (G % 8 == 0) ? (bx % 8) * (G / 8) + bx / 8 : bx; F.gw = F.vcu * NWAVES + F.wave; F.NGW = G * NWAVES;
}
__device__ __forceinline__ void launder_args(Args& a, Frame& F) { asm volatile("" : "+s"(a.ws), "+s"(a.out)); asm volatile("" : "+s"(F.wave)); frame_init(F, F.lds); }
constexpr int PH_PER_LAYER = 7, N_PHASES = 1 + 2 * PH_PER_LAYER;
__device__ __forceinline__ Args load_args() {
#if defined(__HIP_DEVICE_COMPILE__)
    const __attribute__((address_space(4))) unsigned long long* p = (const __attribute__((address_space(4))) unsigned long long*)__builtin_amdgcn_kernarg_segment_ptr();
    asm volatile("" : "+s"(p));
    struct Raw { unsigned long long w[sizeof(Args) / 8]; } r;
#pragma unroll
    for (int i = 0; i < (int)(sizeof(Args) / 8); ++i) r.w[i] = p[i];
    return __builtin_bit_cast(Args, r);
#else
    return Args{};
#endif
}
__global__ void __launch_bounds__(NWAVES * 64, 2) fwd_kernel(Args a0_unused) {
    extern __shared__ __attribute__((aligned(16))) unsigned char lds[];
    Frame F; F.wave = __builtin_amdgcn_readfirstlane((int)threadIdx.x >> 6); frame_init(F, (LAS unsigned char*)lds);
    for (int u = F.tid; u < (LDS_BYTES - LDSCTL_OFF) / 4; u += NWAVES * 64) ((LAS unsigned*)(F.lds + LDSCTL_OFF))[u] = 0u;
    __syncthreads();
    volatile LAS unsigned* MISC = (volatile LAS unsigned*)((LAS unsigned char*)lds + MISC_OFF);
    { gu32* ctl = (gu32*)(load_args().ws + WS_CTL); (void)xcd_barrier_post((unsigned*)(ctl + CW_BAR), MISC + 8, F.tid); }
#define IN(k) (true)
#define LAUNDER if (Args a = load_args(); true) if ((launder_args(a, F)), true)
#define SEAM(k) do { if ((k) + 1 < N_PHASES) { unsigned char* wsl_ = load_args().ws; asm volatile("" : "+s"(wsl_)); XcdBarrier bar_; bar_.bar = (unsigned*)(wsl_ + WS_CTL) + CW_BAR; bar_.x = xb_xcc_id(); \
        bar_.st = (volatile LAS unsigned*)((LAS unsigned char*)lds + MISC_OFF) + 8; xcd_barrier(bar_, F.wave * 64 + lane_now()); } } while (0)
    for (int rep_ = 0; rep_ < (PROBE_DUP == 99 ? 2 : 1); ++rep_)
    if (IN(0)) LAUNDER p0_prologue(a, F);
    SEAM(0);
#pragma unroll 1
    for (int l = 0; l < 2; ++l) {
        const int pb = 1 + PH_PER_LAYER * l;
        for (int rep_ = 0; rep_ < (PROBE_DUP == 100 ? 2 : 1); ++rep_)
        if (IN(pb + 0)) LAUNDER {
            pg8::Gemm g{wsb(a, l == 0 ? WS_XN : WS_XN1), wsb(a, WS_WIN + l * 5 * MiB), M, NPROJ, 1024}; pg8::StaticOrder S; S.init(M, NPROJ, F.G, (int)blockIdx.x);
            typedef pg8::EpiPk<1, 0, false> EP; EP E{wsb(a, WS_GQ), wsb(a, WS_GK), wsb(a, WS_GV), wsb(a, WS_GG), wsb(a, WS_REST), 512, nullptr};
            pg8::gemm_phase<EP, pg8::StaticOrder, true>(F.lds + RING_OFF, g, S, E, F.tid);
        }
        SEAM(pb + 0);
        for (int rep2_ = 0; rep2_ < (PROBE_DUP == 101 ? 2 : 1); ++rep2_) {
        for (int r3_ = 0; r3_ < (PROBE_DUP == 111 ? 2 : 1); ++r3_)
        if (IN(pb + 1)) LAUNDER mla_side(a, F, l);
        for (int r4_ = 0; r4_ < (PROBE_DUP == 112 ? 2 : 1); ++r4_)
        if (IN(pb + 1)) LAUNDER {
            pg8::StaticOrder S; S.init(M, 768, F.G, (int)blockIdx.x);
            { pg8::Unit u; for (int i = 0; S.next(i, u); ++i) norm_panel<256>(F, wsb(a, WS_REST), R_CQ, QSCALE, wsb(a, WS_CQN), u.pm * 256); }
            S.init(M, 1024, F.G, (int)blockIdx.x);
            { pg8::Unit u; for (int i = 0; S.next(i, u); ++i) norm_panel<128>(F, wsb(a, WS_REST), R_CKV, 1.f, wsb(a, WS_CKVN), u.pm * 256); }
            VM_WAIT(); __syncthreads();
        }
        for (int r5_ = 0; r5_ < (PROBE_DUP == 113 ? 2 : 1); ++r5_)
        if (IN(pb + 1)) LAUNDER {
            pg8::Gemm g{wsb(a, WS_CQN), wsb(a, WS_WQ + l * 384 * KiB), M, 768, 256}; pg8::StaticOrder S; S.init(M, 768, F.G, (int)blockIdx.x);
            typedef pg8::EpiPk<0, 0, false> EP; EP E{wsb(a, WS_Q), nullptr, nullptr, nullptr, nullptr, 768, nullptr};
            pg8::gemm_phase<EP, pg8::StaticOrder, true>(F.lds + RING_OFF, g, S, E, F.tid);
        }
        for (int r6_ = 0; r6_ < (PROBE_DUP == 115 ? 2 : 1); ++r6_)
        if (IN(pb + 1)) LAUNDER {
            pg8::Gemm g{wsb(a, WS_CKVN), wsb(a, WS_WKV + l * 256 * KiB), M, 1024, 128}; pg8::StaticOrder S; S.init(M, 1024, F.G, (int)blockIdx.x);
            typedef pg8::EpiPk<2, 0, false> EP; EP E{wsb(a, WS_K), wsb(a, WS_V), nullptr, nullptr, nullptr, 0, nullptr};
            pg8::gemm_phase<EP, pg8::StaticOrder, true>(F.lds + RING_OFF, g, S, E, F.tid);
        }
        }
        SEAM(pb + 1);
        for (int rep_ = 0; rep_ < (PROBE_DUP == 102 ? 2 : 1); ++rep_)
        if (IN(pb + 2)) LAUNDER gdn_prep_phase(a, F, l, (char*)lds + RING_OFF);
        SEAM(pb + 2);
        if (IN(pb + 3)) LAUNDER p3_phase(a, F, l, (char*)lds + RING_OFF, (volatile LAS unsigned*)((LAS unsigned char*)lds + MISC_OFF));
        SEAM(pb + 3);
        if (PROBE_DUP == 5 || PROBE_DUP == 50 || PROBE_DUP == 51 || (PROBE_DUP >= 60 && PROBE_DUP < 76) || (PROBE_DUP >= 300 && PROBE_DUP < 428)) { LAUNDER p3_phase(a, F, l, (char*)lds + RING_OFF, (volatile LAS unsigned*)((LAS unsigned char*)lds + MISC_OFF), 1, PROBE_DUP != 51 && PROBE_DUP < 300, PROBE_DUP == 5 || PROBE_DUP == 51 || PROBE_DUP >= 300); SEAM(pb + 3); }
        if (IN(pb + 4)) LAUNDER {
            pg8::Gemm g{wsb(a, WS_CAT), wsb(a, WS_WOUT + l * 2 * MiB), M, 1024, 1024}; pg8::StaticOrder S; S.init(M, 1024, F.G, (int)blockIdx.x);
            unsigned* ctlw = (unsigned*)(a.ws + WS_CTL);
            pg8::PanelRms st1{wsf(a, WS_XCH) + (size_t)(l * 4 + 0) * 65536, ctlw + CW_SEAM + (l * 4 + 0) * SEAM_BANK, ctlw + CW_TMO, EPS};
            pg8::PanelRms st2{wsf(a, WS_XCH) + (size_t)(l * 4 + 1) * 65536, ctlw + CW_SEAM + (l * 4 + 1) * SEAM_BANK, ctlw + CW_TMO, EPS};
            pg8::EpiRmsResRms E{l == 0 ? (const void*)a.x : (const void*)((const char*)a.out + 32 * MiB), l == 0 ? (void*)a.out : (void*)(a.ws + WS_R3), wsb(a, WS_XN), a.mix_post + l * D, a.ffn_pre + l * D, st1, st2, l, 1};
            pg8::gemm_phase<pg8::EpiRmsResRms, pg8::StaticOrder, false>(F.lds + RING_OFF, g, S, E, F.tid);
        }
        if (PROBE_DUP == 104) { SEAM(pb + 3); LAUNDER {
            pg8::Gemm g{wsb(a, WS_CAT), wsb(a, WS_WOUT + l * 2 * MiB), M, 1024, 1024}; pg8::StaticOrder S; S.init(M, 1024, F.G, (int)blockIdx.x);
            unsigned* ctlw = (unsigned*)(a.ws + WS_CTL);
            pg8::PanelRms st1{wsf(a, WS_XCH) + (size_t)(l * 4 + 0) * 65536, ctlw + CW_SEAM + (8 + l * 4 + 0) * SEAM_BANK, ctlw + CW_TMO, EPS};
            pg8::PanelRms st2{wsf(a, WS_XCH) + (size_t)(l * 4 + 1) * 65536, ctlw + CW_SEAM + (8 + l * 4 + 1) * SEAM_BANK, ctlw + CW_TMO, EPS};
            pg8::EpiRmsResRms E{a.x, wsf(a, WS_Q), wsb(a, WS_OPSX), a.mix_post + l * D, a.ffn_pre + l * D, st1, st2, 0, 0};
            pg8::gemm_phase<pg8::EpiRmsResRms, pg8::StaticOrder, false>(F.lds + RING_OFF, g, S, E, F.tid); } }
        if (PROBE_DUP == 114) { SEAM(pb + 3); LAUNDER {
            pg8::Gemm g{wsb(a, WS_CAT), wsb(a, WS_WOUT + l * 2 * MiB), M, 1024, 1024}; pg8::StaticOrder S; S.init(M, 1024, F.G, (int)blockIdx.x);
            pg8::EpiF32 E{wsf(a, WS_Q), 1024};
            pg8::gemm_phase<pg8::EpiF32, pg8::StaticOrder, false>(F.lds + RING_OFF, g, S, E, F.tid); } }
        SEAM(pb + 4);
        for (int rep_ = 0; rep_ < (PROBE_DUP == 105 ? 2 : 1); ++rep_)
        if (IN(pb + 5)) LAUNDER {
            pg8::Gemm g{wsb(a, WS_XN), wsb(a, WS_WUP + l * 8 * MiB), M, FF, 1024}; pg8::StaticOrder S; S.init(M, FF, F.G, (int)blockIdx.x);
            typedef pg8::EpiPk<0, 2, false> EP; EP E{wsb(a, WS_H), nullptr, nullptr, nullptr, nullptr, FF, nullptr};
            pg8::gemm_phase<EP, pg8::StaticOrder, true>(F.lds + RING_OFF, g, S, E, F.tid);
        }
        SEAM(pb + 5);
        if (PROBE_DUP == 400) { SEAM(pb + 5); SEAM(pb + 5); SEAM(pb + 5); SEAM(pb + 5); }
        if (IN(pb + 6)) LAUNDER {
            pg8::Gemm g{wsb(a, WS_H), wsb(a, WS_WDN + l * 8 * MiB), M, 1024, FF}; pg8::StaticOrder S; S.init(M, 1024, F.G, (int)blockIdx.x);
            unsigned* ctlw = (unsigned*)(a.ws + WS_CTL);
            pg8::PanelRms st1{wsf(a, WS_XCH) + (size_t)(l * 4 + 2) * 65536, ctlw + CW_SEAM + (l * 4 + 2) * SEAM_BANK, ctlw + CW_TMO, EPS};
            pg8::PanelRms st2{wsf(a, WS_XCH) + (size_t)(l * 4 + 3) * 65536, ctlw + CW_SEAM + (l * 4 + 3) * SEAM_BANK, ctlw + CW_TMO, EPS};
            pg8::EpiRmsResRms E{l == 0 ? (const void*)a.out : (const void*)(a.ws + WS_R3), l == 0 ? (void*)((char*)a.out + 32 * MiB) : (void*)a.out, l == 0 ? wsb(a, WS_XN1) : nullptr, a.ffn_post + l * D, a.mix_pre + D, st1, st2, 1, l == 0};
            pg8::gemm_phase<pg8::EpiRmsResRms, pg8::StaticOrder, false>(F.lds + RING_OFF, g, S, E, F.tid);
        }
        if (PROBE_DUP == 106) { SEAM(pb + 5); LAUNDER {
            pg8::Gemm g{wsb(a, WS_H), wsb(a, WS_WDN + l * 8 * MiB), M, 1024, FF}; pg8::StaticOrder S; S.init(M, 1024, F.G, (int)blockIdx.x);
            unsigned* ctlw = (unsigned*)(a.ws + WS_CTL);
            pg8::PanelRms st1{wsf(a, WS_XCH) + (size_t)(l * 4 + 2) * 65536, ctlw + CW_SEAM + (8 + l * 4 + 2) * SEAM_BANK, ctlw + CW_TMO, EPS};
            pg8::PanelRms st2{wsf(a, WS_XCH) + (size_t)(l * 4 + 3) * 65536, ctlw + CW_SEAM + (8 + l * 4 + 3) * SEAM_BANK, ctlw + CW_TMO, EPS};
            pg8::EpiRmsResRms E{a.x, wsf(a, WS_XN), nullptr, a.ffn_post + l * D, a.mix_pre + D, st1, st2, 0, 0};
            pg8::gemm_phase<pg8::EpiRmsResRms, pg8::StaticOrder, false>(F.lds + RING_OFF, g, S, E, F.tid); } }
        SEAM(pb + 6);
            }
#undef IN
#undef SEAM
}

#ifndef MK_SPLIT
#define MK_SPLIT 0
#endif
extern "C" void kernel_launch(void* const* d_in, const int* in_sizes, int n_in, void* d_out, int out_size, void* d_ws, size_t ws_size, hipStream_t stream) {
    static int grid = 0;
    if (grid == 0) {
        if (n_in != 18 || in_sizes[0] != M * D || out_size != M * D || ws_size < WS_END) { fprintf(stderr, "kernel_launch: unexpected shapes (n_in %d, in0 %d, out %d, ws %zu)\n", n_in, n_in > 0 ? in_sizes[0] : -1, out_size, ws_size); grid = -1; return; }
        int dev = 0, cus = 0, per_cu = 0;
        if (hipGetDevice(&dev) != hipSuccess || hipDeviceGetAttribute(&cus, hipDeviceAttributeMultiprocessorCount, dev) != hipSuccess) { grid = -1; return; }
        if (hipFuncSetAttribute((const void*)fwd_kernel, hipFuncAttributeMaxDynamicSharedMemorySize, LDS_BYTES) != hipSuccess) { fprintf(stderr, "kernel_launch: hipFuncSetAttribute failed\n"); grid = -1; return; }
        if (hipOccupancyMaxActiveBlocksPerMultiprocessor(&per_cu, (const void*)fwd_kernel, NWAVES * 64, LDS_BYTES) != hipSuccess || per_cu < 1) fprintf(stderr, "kernel_launch: occupancy query reports %d\n", per_cu);
        (void)hipGetLastError();
        grid = cus;
    }
    if (grid < 0) return;
    if (hipMemsetAsync((char*)d_ws + WS_CTL, 0, CTL_ZERO_BYTES, stream) != hipSuccess) { fprintf(stderr, "kernel_launch: memset failed\n"); return; }
    Args a{};
    a.x = (const float*)d_in[0]; a.pos = (const int*)d_in[1]; a.mix_pre = (const float*)d_in[2]; a.w_in = (const float*)d_in[3]; a.conv_w = (const float*)d_in[4];
    a.a_log = (const float*)d_in[5]; a.dt_bias = (const float*)d_in[6]; a.gdn_norm = (const float*)d_in[7]; a.q_norm = (const float*)d_in[8]; a.w_q_up = (const float*)d_in[9];
    a.kv_norm = (const float*)d_in[10]; a.w_kv_up = (const float*)d_in[11]; a.w_out = (const float*)d_in[12]; a.mix_post = (const float*)d_in[13]; a.ffn_pre = (const float*)d_in[14];
    a.w_up = (const float*)d_in[15]; a.w_down = (const float*)d_in[16]; a.ffn_post = (const float*)d_in[17];
    a.out = (float*)d_out; a.ws = (unsigned char*)d_ws;
    a.ph_lo = 0; a.ph_hi = N_PHASES;
    hipLaunchKernelGGL(fwd_kernel, dim3(grid), dim3(NWAVES * 64), LDS_BYTES, stream, a);
    const hipError_t le = hipPeekAtLastError();
    if (le != hipSuccess) fprintf(stderr, "kernel_launch: launch failed: %s\n", hipGetErrorName(le));
}
```

```cpp
#include <hip/hip_runtime.h>
#include <cstdio>
#include <cstdint>
namespace pg8 {
#define PG8_LAS __attribute__((address_space(3)))
typedef unsigned short bf16_t;
typedef short bf16x8 __attribute__((ext_vector_type(8)));
typedef float f32x4 __attribute__((ext_vector_type(4)));
typedef unsigned u32x4 __attribute__((ext_vector_type(4)));
constexpr int BM = 256, BK = 64, HALF = 128, HTB = HALF * BK * 2  , STAGE_BYTES = 8 * HTB, NXCD = 8, WGM = 8;

__host__ __device__ __forceinline__ int lds_byte(int r, int c) { const int st = (r >> 4) * 2 + (c >> 5), rr = r & 15, cc = c & 31, ob = rr * 64 + cc * 2; return st * 1024 + (ob ^ (((ob >> 9) & 1) << 5)); }
__host__ __device__ __forceinline__ void stage_rc(int b, int& R, int& C) { const int st = b / 1024, sb = b % 1024, swz = sb ^ (((sb >> 9) & 1) << 5); R = (st >> 1) * 16 + swz / 64; C = (st & 1) * 32 + (swz % 64) / 2; }
__host__ __device__ __forceinline__ int perm32(int rho) { const int n = rho >> 4, i = rho & 15; return 8 * (i >> 2) + 4 * n + (i & 3); }

struct Unit { int pm, pn; };
struct Gemm { const bf16_t* A; const bf16_t* Bt; int M, N, K; };

struct StaticOrder {
    int nM, nN, nwg, G, c;
    __host__ __device__ __forceinline__ void init(int M, int N, int G_, int c_) { nM = M / BM; nN = N / BM; nwg = nM * nN; G = G_; c = c_; }
    __host__ __device__ __forceinline__ bool next(int i, Unit& u) const {
        const long L = (long)i * G + c; if (L >= nwg) return false;
        int wgid = (int)L; { const int q = nwg / NXCD, r = nwg % NXCD, xcd = wgid % NXCD, off = wgid / NXCD; wgid = (xcd < r ? xcd * (q + 1) : r * (q + 1) + (xcd - r) * q) + off; }
        const int nig = WGM * nN, gid = wgid / nig, fm = gid * WGM, gsz = (nM - fm) < WGM ? (nM - fm) : WGM;
        u.pm = fm + ((wgid % nig) % gsz); u.pn = (wgid % nig) / gsz; return true;
    }
    __device__ __forceinline__ void a_ready(const Unit&) const {}
    __device__ __forceinline__ void done(const Unit&) const {}
};

__device__ __forceinline__ float shx(float v, int lane, int o) { return __builtin_bit_cast(float, __builtin_amdgcn_ds_bpermute((lane ^ o) << 2, __builtin_bit_cast(int, v))); }
__device__ __forceinline__ unsigned cvt_pk_bf16(float lo, float hi) { unsigned r; asm volatile("v_cvt_pk_bf16_f32 %0, %1, %2" : "=v"(r) : "v"(lo), "v"(hi)); return r; }

template <int mode, int act, bool HAS_SCALE> struct EpiPk {
    static constexpr bool PERM = true, AFTER_DRAIN = false;
    bf16_t *p0, *p1, *p2, *p3, *p4; int ldc; const float* rowscale;
    __device__ __forceinline__ bf16_t* dst(int row, int col) const {
        if (mode == 0) return p0 + (size_t)row * ldc + col;
        if (mode == 1) { const int pt = col >> 9; bf16_t* b = pt == 0 ? p0 : pt == 1 ? p1 : pt == 2 ? p2 : pt == 3 ? p3 : p4; return b + (size_t)row * 512 + (col & 511); }
        const int h = col >> 7, d = col & 127;
        return d < 64 ? p0 + (size_t)row * 768 + h * 96 + d : p1 + (size_t)row * 512 + h * 64 + (d - 64);
    }
    __device__ __forceinline__ void operator()(const f32x4 (&acc)[2][2][4][2], const Unit& u, int wr, int wc, int fr, int fq) const {
        const int row0 = u.pm * BM + wr * 64 + fr, col0 = u.pn * BM + wc * 32 + 8 * fq;
#pragma unroll
        for (int ai = 0; ai < 2; ++ai)
#pragma unroll
            for (int m = 0; m < 4; ++m) { const int row = row0 + ai * HALF + m * 16; const float sc = HAS_SCALE ? rowscale[row] : 1.f;
#pragma unroll
                for (int bj = 0; bj < 2; ++bj) { f32x4 v0 = acc[ai][bj][m][0], v1 = acc[ai][bj][m][1];
                    if (act == 2) {
#pragma unroll
                        for (int e = 0; e < 4; ++e) { v0[e] = v0[e] > 0.f ? v0[e] * v0[e] : 0.f; v1[e] = v1[e] > 0.f ? v1[e] * v1[e] : 0.f; } }
                    if (mode == 1 && ((col0 + bj * HALF) >> 9) == 3) {
#pragma unroll
                        for (int e = 0; e < 4; ++e) { v0[e] = v0[e] * __builtin_amdgcn_rcpf(1.f + __expf(-v0[e])); v1[e] = v1[e] * __builtin_amdgcn_rcpf(1.f + __expf(-v1[e])); } }
                    v0 = v0 * sc; v1 = v1 * sc; u32x4 w; w.x = cvt_pk_bf16(v0[0], v0[1]); w.y = cvt_pk_bf16(v0[2], v0[3]); w.z = cvt_pk_bf16(v1[0], v1[1]); w.w = cvt_pk_bf16(v1[2], v1[3]);
                    *(u32x4*)dst(row, col0 + bj * HALF) = w; } }
    }
};
struct EpiF32 {
    static constexpr bool PERM = false, AFTER_DRAIN = false;
    float* O; int ldc;
    __device__ __forceinline__ void operator()(const f32x4 (&acc)[2][2][4][2], const Unit& u, int wr, int wc, int fr, int fq) const {
        const int row0 = u.pm * BM + wr * 64 + fr, col0 = u.pn * BM + wc * 32 + 4 * fq;
#pragma unroll
        for (int ai = 0; ai < 2; ++ai)
#pragma unroll
            for (int m = 0; m < 4; ++m) { float* rowp = O + (size_t)(row0 + ai * HALF + m * 16) * ldc + col0;
#pragma unroll
                for (int bj = 0; bj < 2; ++bj)
#pragma unroll
                    for (int n = 0; n < 2; ++n) *(f32x4*)(rowp + bj * HALF + n * 16) = acc[ai][bj][m][n]; }
    }
};

struct PanelRms {
    float* xbuf;
    unsigned* cnt;
    unsigned* tmo;
    float eps;
    __device__ __forceinline__ void run(const f32x4 (&v)[2][2][4][2], const Unit& u, int wr, int wc, int fr, int fq, PG8_LAS unsigned char* lds, int wid, int lane) const {
        PG8_LAS float* P = (PG8_LAS float*)lds;
        PG8_LAS float* S = (PG8_LAS float*)(lds + 8192);
#pragma unroll
        for (int ai = 0; ai < 2; ++ai)
#pragma unroll
            for (int m = 0; m < 4; ++m) {
                float q = 0.f;
#pragma unroll
                for (int bj = 0; bj < 2; ++bj)
#pragma unroll
                    for (int n = 0; n < 2; ++n) { const f32x4 d = v[ai][bj][m][n]; q += (d[0] * d[0] + d[1] * d[1]) + (d[2] * d[2] + d[3] * d[3]); }
                q += shx(q, lane, 16); q += shx(q, lane, 32);
                if (fq == 0) P[(ai * HALF + wr * 64 + m * 16 + fr) * 4 + wc] = q;
            }
        asm volatile("s_waitcnt lgkmcnt(0)" ::: "memory"); __builtin_amdgcn_s_barrier(); asm volatile("" ::: "memory");
        const int row = wid * 32 + (lane & 31);
        if (lane < 32) {
            const float t = (P[row * 4 + 0] + P[row * 4 + 1]) + (P[row * 4 + 2] + P[row * 4 + 3]);
            __hip_atomic_store(xbuf + ((size_t)(u.pm * BM + row) * 4 + u.pn), t, __ATOMIC_RELAXED, __HIP_MEMORY_SCOPE_AGENT);
        }
        asm volatile("s_waitcnt vmcnt(0)" ::: "memory");
        if (lane == 0) __hip_atomic_fetch_add(cnt + 64 * u.pm, 1u, __ATOMIC_RELAXED, __HIP_MEMORY_SCOPE_AGENT);
        if (wid == 0) {
            while ((unsigned)__builtin_amdgcn_readfirstlane(__hip_atomic_load(cnt + 64 * u.pm, __ATOMIC_RELAXED, __HIP_MEMORY_SCOPE_AGENT)) < 32u) __builtin_amdgcn_s_sleep(2);
            __builtin_amdgcn_fence(__ATOMIC_ACQUIRE, "agent");
        }
        asm volatile("s_waitcnt vmcnt(0) lgkmcnt(0)" ::: "memory"); __builtin_amdgcn_s_barrier(); asm volatile("" ::: "memory");
        if (lane < 32) {
            const float* slot = xbuf + (size_t)(u.pm * BM + row) * 4; float tot = 0.f;
#pragma unroll
            for (int t = 0; t < 4; ++t) tot += __hip_atomic_load(slot + t, __ATOMIC_RELAXED, __HIP_MEMORY_SCOPE_AGENT);
            S[row] = 1.0f / sqrtf(tot * (1.0f / 1024.0f) + eps);
        }
        asm volatile("s_waitcnt lgkmcnt(0)" ::: "memory"); __builtin_amdgcn_s_barrier(); asm volatile("" ::: "memory");
    }
};
struct EpiRmsResRms {
    static constexpr bool PERM = false, AFTER_DRAIN = true;
    const void* base; void* out; bf16_t* xn; const float* g1; const float* g2; PanelRms st1, st2; int base_bf, out_bf;
    __device__ __forceinline__ void fused(f32x4 (&acc)[2][2][4][2], const Unit& u, int wr, int wc, int fr, int fq, PG8_LAS unsigned char* lds, int wid, int lane) const {
        typedef unsigned u32x2v __attribute__((ext_vector_type(2)));
        const PG8_LAS float* S = (const PG8_LAS float*)(lds + 8192);
        const int col0 = u.pn * BM + wc * 32 + 4 * fq;
        st1.run(acc, u, wr, wc, fr, fq, lds, wid, lane);
#pragma unroll
        for (int ai = 0; ai < 2; ++ai)
#pragma unroll
            for (int m = 0; m < 4; ++m) { const int r = ai * HALF + wr * 64 + m * 16 + fr; const float sr = S[r]; const size_t off = (size_t)(u.pm * BM + r) * 1024 + col0;
                f32x4 bs[2][2];
                if (base_bf) {
#pragma unroll
                    for (int bj = 0; bj < 2; ++bj)
#pragma unroll
                        for (int n = 0; n < 2; ++n) { const u32x2v w = *(const u32x2v*)((const bf16_t*)base + off + bj * HALF + n * 16);
                            bs[bj][n] = (f32x4){__builtin_bit_cast(float, w.x << 16), __builtin_bit_cast(float, w.x & 0xffff0000u), __builtin_bit_cast(float, w.y << 16), __builtin_bit_cast(float, w.y & 0xffff0000u)}; }
                } else {
#pragma unroll
                    for (int bj = 0; bj < 2; ++bj)
#pragma unroll
                        for (int n = 0; n < 2; ++n) bs[bj][n] = *(const f32x4*)((const float*)base + off + bj * HALF + n * 16);
                }
#pragma unroll
                for (int bj = 0; bj < 2; ++bj)
#pragma unroll
                    for (int n = 0; n < 2; ++n) { const f32x4 gv = *(const f32x4*)(g1 + col0 + bj * HALF + n * 16); acc[ai][bj][m][n] = bs[bj][n] + acc[ai][bj][m][n] * sr * gv; }
                asm volatile("" : "+v"(acc[ai][0][m][0]), "+v"(acc[ai][0][m][1]), "+v"(acc[ai][1][m][0]), "+v"(acc[ai][1][m][1]));
                if (m & 1) asm volatile("" ::: "memory"); }
        if (xn) st2.run(acc, u, wr, wc, fr, fq, lds, wid, lane);
#pragma unroll
        for (int ai = 0; ai < 2; ++ai)
#pragma unroll
            for (int m = 0; m < 4; ++m) { const int r = ai * HALF + wr * 64 + m * 16 + fr; const float sr = S[r]; const size_t off = (size_t)(u.pm * BM + r) * 1024 + col0;
#pragma unroll
                for (int bj = 0; bj < 2; ++bj)
#pragma unroll
                    for (int n = 0; n < 2; ++n) { const f32x4 x1 = acc[ai][bj][m][n]; if (out_bf) { u32x2v w; w.x = cvt_pk_bf16(x1[0], x1[1]); w.y = cvt_pk_bf16(x1[2], x1[3]); *(u32x2v*)((bf16_t*)out + off + bj * HALF + n * 16) = w; } else *(f32x4*)((float*)out + off + bj * HALF + n * 16) = x1;
                        if (xn) { const f32x4 gv = *(const f32x4*)(g2 + col0 + bj * HALF + n * 16); const f32x4 o = x1 * sr * gv; u32x2v w; w.x = cvt_pk_bf16(o[0], o[1]); w.y = cvt_pk_bf16(o[2], o[3]); *(u32x2v*)(xn + off + bj * HALF + n * 16) = w; } }
                asm volatile("" ::: "memory"); }
    }
};

template <class Epi, class Sched, bool ALIGN_EPI = false>
__device__ __forceinline__ void gemm_phase(PG8_LAS unsigned char* lds, const Gemm g, const Sched& S, const Epi& E, int tid_in) {
    int tid_ = tid_in; asm volatile("" : "+v"(tid_));
    const int tid = tid_, wid = __builtin_amdgcn_readfirstlane(tid >> 6), lane = tid & 63, wr = wid >> 2, wc = wid & 3, fr = lane & 15, fq = lane >> 4;
    int K_ = g.K; asm volatile("" : "+s"(K_));
    const int K = K_, nt = K / BK;
    unsigned voffA[2], voffB[2];
#pragma unroll
    for (int i = 0; i < 2; ++i) { int R, C; stage_rc(tid * 16 + i * 8192, R, C); const int Rb = Epi::PERM ? ((R & ~31) + perm32(R & 31)) : R;
        voffA[i] = (unsigned)(R * K + C) * 2u; voffB[i] = (unsigned)(Rb * K + C) * 2u; }
    const size_t kstep = (size_t)(BK * 2);
    const size_t hstep = (size_t)HALF * K * 2;
    const size_t tstep = 2 * hstep;
    const unsigned ldsw = (unsigned)wid * 1024u;
    const int aoff = lds_byte(wr * 64 + fr, fq * 8), boff = lds_byte(wc * 32 + fr, fq * 8);
#define PG8_SA(b, h) (((b) * 2 + (h)) * HTB)
#define PG8_SB(b, h) ((4 + (b) * 2 + (h)) * HTB)
#define PG8_STAGE(bufoff, gbase, voff) do { _Pragma("unroll") for (int _i = 0; _i < 2; ++_i) \
        __builtin_amdgcn_global_load_lds((const unsigned*)((const char*)(gbase) + (voff)[_i]), (PG8_LAS unsigned*)(lds + (bufoff) + ldsw + _i * 8192), 16, 0, 0); } while (0)
#define PG8_LDA(dst, b, h) do { _Pragma("unroll") for (int m = 0; m < 4; ++m) _Pragma("unroll") for (int k = 0; k < 2; ++k) dst[m][k] = *(const PG8_LAS bf16x8*)(lds + PG8_SA(b, h) + aoff + m * 2048 + k * 1024); } while (0)
#define PG8_LDB(dst, b, h) do { _Pragma("unroll") for (int n = 0; n < 2; ++n) _Pragma("unroll") for (int k = 0; k < 2; ++k) dst[n][k] = *(const PG8_LAS bf16x8*)(lds + PG8_SB(b, h) + boff + n * 2048 + k * 1024); } while (0)
#define PG8_MMA(ai, bj, At, Bt) do { __builtin_amdgcn_s_setprio(1); _Pragma("unroll") for (int m = 0; m < 4; ++m) _Pragma("unroll") for (int n = 0; n < 2; ++n) _Pragma("unroll") for (int k = 0; k < 2; ++k) \
        acc[ai][bj][m][n] = __builtin_amdgcn_mfma_f32_16x16x32_bf16(Bt[n][k], At[m][k], acc[ai][bj][m][n], 0, 0, 0); __builtin_amdgcn_s_setprio(0); } while (0)
#define PG8_WAIT_V(n) asm volatile("s_waitcnt vmcnt(" #n ")" ::: "memory")
#define PG8_WAIT_L(n) asm volatile("s_waitcnt lgkmcnt(" #n ")" ::: "memory")
#define PG8_BAR __builtin_amdgcn_s_barrier()
#define PG8_SCHED __builtin_amdgcn_sched_barrier(0)
    Unit cur, nxt; int ui = 0;
    if (!S.next(0, cur)) return;
    f32x4 acc[2][2][4][2];
#pragma unroll
    for (int a = 0; a < 2; ++a)
#pragma unroll
        for (int b = 0; b < 2; ++b)
#pragma unroll
            for (int m = 0; m < 4; ++m)
#pragma unroll
                for (int n = 0; n < 2; ++n) acc[a][b][m][n] = (f32x4){0.f, 0.f, 0.f, 0.f};
    bf16x8 At[4][2], B0[2][2], B1[2][2];
    const char* cA = (const char*)g.A + (size_t)cur.pm * tstep; const char* cB = (const char*)g.Bt + (size_t)cur.pn * tstep;
    S.a_ready(cur);
    PG8_STAGE(PG8_SB(0, 0), cB, voffB); PG8_STAGE(PG8_SB(0, 1), cB + hstep, voffB); PG8_STAGE(PG8_SA(0, 0), cA, voffA); PG8_STAGE(PG8_SA(0, 1), cA + hstep, voffA);
    if (wr == 1) PG8_BAR;
    PG8_WAIT_V(2); PG8_BAR;
    PG8_STAGE(PG8_SB(1, 0), cB + kstep, voffB); PG8_STAGE(PG8_SA(1, 0), cA + kstep, voffA); PG8_STAGE(PG8_SB(1, 1), cB + hstep + kstep, voffB);
    PG8_WAIT_V(6); PG8_BAR;
    for (;;) {
        const bool has_next = S.next(ui + 1, nxt);
        const char* nA = has_next ? (const char*)g.A + (size_t)nxt.pm * tstep : cA; const char* nB = has_next ? (const char*)g.Bt + (size_t)nxt.pn * tstep : cB;
        for (int t = 0; t < nt; t += 2) {
            const bool last = (t == nt - 2);
            const char* a1 = cA + (size_t)(t + 1) * kstep;
            const char* a2 = last ? nA : cA + (size_t)(t + 2) * kstep; const char* b2 = last ? nB : cB + (size_t)(t + 2) * kstep;
            const char* a3 = a2 + kstep; const char* b3 = b2 + kstep;
            if (last && has_next) S.a_ready(nxt);
            PG8_LDB(B0, 0, 0); PG8_LDB(B1, 0, 1); PG8_SCHED; PG8_LDA(At, 0, 0); PG8_STAGE(PG8_SA(1, 1), a1 + hstep, voffA);
            PG8_WAIT_V(8); PG8_WAIT_L(0); PG8_BAR; PG8_MMA(0, 0, At, B0); PG8_MMA(0, 1, At, B1); PG8_BAR; PG8_SCHED;
            PG8_LDA(At, 0, 1); PG8_STAGE(PG8_SB(0, 0), b2, voffB); PG8_STAGE(PG8_SB(0, 1), b2 + hstep, voffB); PG8_STAGE(PG8_SA(0, 0), a2, voffA);
            PG8_WAIT_V(8); PG8_WAIT_L(0); PG8_BAR; PG8_MMA(1, 0, At, B0); PG8_MMA(1, 1, At, B1); PG8_BAR; PG8_SCHED;
            PG8_LDB(B0, 1, 0); PG8_LDB(B1, 1, 1); PG8_SCHED; PG8_LDA(At, 1, 0); PG8_STAGE(PG8_SA(0, 1), a2 + hstep, voffA);
            PG8_WAIT_V(8); PG8_WAIT_L(0); PG8_BAR; PG8_MMA(0, 0, At, B0); PG8_MMA(0, 1, At, B1); PG8_BAR; PG8_SCHED;
            PG8_LDA(At, 1, 1); PG8_STAGE(PG8_SB(1, 0), b3, voffB); PG8_STAGE(PG8_SB(1, 1), b3 + hstep, voffB); PG8_STAGE(PG8_SA(1, 0), a3, voffA);
            PG8_WAIT_V(8); PG8_WAIT_L(0); PG8_BAR; PG8_MMA(1, 0, At, B0); PG8_MMA(1, 1, At, B1); PG8_BAR; PG8_SCHED;
        }
        if constexpr (ALIGN_EPI) { if (wr == 0) PG8_BAR; }
        if constexpr (!Epi::AFTER_DRAIN) { E(acc, cur, wr, wc, fr, fq); S.done(cur); }
        if (!has_next) break;
#pragma unroll
        for (int a = 0; a < 2; ++a)
#pragma unroll
            for (int b = 0; b < 2; ++b)
#pragma unroll
                for (int m = 0; m < 4; ++m)
#pragma unroll
                    for (int n = 0; n < 2; ++n) acc[a][b][m][n] = (f32x4){0.f, 0.f, 0.f, 0.f};
        cur = nxt; cA = nA; cB = nB; ++ui;
        if constexpr (ALIGN_EPI) { if (wr == 1) PG8_BAR; }
    }
    PG8_WAIT_V(0);
    if constexpr (!ALIGN_EPI) { if (wr == 0) PG8_BAR; }
    PG8_BAR;
    if constexpr (Epi::AFTER_DRAIN) { E.fused(acc, cur, wr, wc, fr, fq, lds, wid, lane); S.done(cur); }
#undef PG8_SA
#undef PG8_SB
#undef PG8_STAGE
#undef PG8_LDA
#undef PG8_LDB
#undef PG8_MMA
#undef PG8_WAIT_V
#undef PG8_WAIT_L
#undef PG8_BAR
#undef PG8_SCHED
}
}
#define GAS __attribute__((address_space(1)))
#define LAS __attribute__((address_space(3)))
typedef unsigned short bf16;
typedef unsigned v4u __attribute__((ext_vector_type(4)));
typedef float f32x4 __attribute__((ext_vector_type(4)));
typedef short bf16x8 __attribute__((ext_vector_type(8)));
typedef GAS unsigned gu32;
#define RLX_AGENT __ATOMIC_RELAXED, __HIP_MEMORY_SCOPE_AGENT
#define LDS_WAIT() asm volatile("s_waitcnt lgkmcnt(0)" ::: "memory")
#define VM_WAIT() asm volatile("s_waitcnt vmcnt(0)" ::: "memory")
__device__ __forceinline__ unsigned f2bf(float f) { unsigned u = __builtin_bit_cast(unsigned, f); return (u + 0x7fffu + ((u >> 16) & 1u)) >> 16; }
__device__ __forceinline__ unsigned pk2(float lo, float hi) { return f2bf(lo) | (f2bf(hi) << 16); }
__device__ __forceinline__ float bf2f(bf16 b) { return __builtin_bit_cast(float, (unsigned)b << 16); }
__device__ __forceinline__ float wave_sum(float v, int lane) {
#pragma unroll
    for (int o = 1; o < 64; o <<= 1) v += pg8::shx(v, lane, o);
    return v;
}
__device__ __forceinline__ int lane_now() { int l; asm volatile("v_mbcnt_lo_u32_b32 %0, -1, 0\n\tv_mbcnt_hi_u32_b32 %0, -1, %0" : "=v"(l)); return l; }
__device__ __forceinline__ float silu_f(float x) { return x / (1.f + __expf(-x)); }

#define XB_TMO      128
#define XB_XCNT(j)  (256  + 64 * (j))
#define XB_XSUB(j)  (1280 + 64 * (j))
#define XB_XGEN(j)  (2304 + 64 * (j))
#define XB_TOP      3328
#define XB_TOPGEN   3392
#define XCD_BAR_WORDS 3456
#define XB_SPIN_CAP (1u << 24)

__device__ __forceinline__ unsigned xb_ld(unsigned* p)              { return __hip_atomic_load(p, __ATOMIC_RELAXED, __HIP_MEMORY_SCOPE_AGENT); }
__device__ __forceinline__ unsigned xb_add(unsigned* p, unsigned v) { return __hip_atomic_fetch_add(p, v, __ATOMIC_RELAXED, __HIP_MEMORY_SCOPE_AGENT); }
__device__ __forceinline__ unsigned xb_xcc_id() { return (unsigned)__builtin_amdgcn_s_getreg((3 << 11) | 20) & 0xFu; }
#define XB_SPIN(cond, bar) do { while (cond) { __builtin_amdgcn_s_sleep(1); } } while (0)

struct XcdBarrier {
    unsigned* bar; unsigned x;
    volatile LAS unsigned* st;
};

__device__ __forceinline__ XcdBarrier xcd_barrier_post(unsigned* bar, volatile LAS unsigned* st, int tid) {
    XcdBarrier b; b.bar = bar; b.x = xb_xcc_id(); b.st = st;
    if (tid == 0) (void)xb_add(&bar[XB_XCNT(b.x)], 1u);
    return b;
}
__device__ __forceinline__ void xcd_barrier_complete(unsigned* bar, unsigned x, unsigned& nloc, unsigned& nx) {
    const unsigned G = gridDim.x * gridDim.y * gridDim.z;
    unsigned sum, cnt, mine;
    for (;;) {
        sum = 0u; cnt = 0u; mine = 0u;
#pragma unroll
        for (unsigned j = 0; j < 16; ++j) { const unsigned c = xb_ld(&bar[XB_XCNT(j)]); sum += c; cnt += (c > 0u) ? 1u : 0u; mine = (j == x) ? c : mine; }
        if (sum == G) break;
        __builtin_amdgcn_s_sleep(1);
    }
    nloc = mine > 0u ? mine : 1u; nx = cnt > 0u ? cnt : 1u;
}

__device__ __forceinline__ void xcd_barrier(const XcdBarrier& b, int tid) {
    asm volatile("s_waitcnt vmcnt(0)" ::: "memory");
    __syncthreads();
    if (tid == 0) {
        unsigned* bar = b.bar;
        __builtin_amdgcn_s_waitcnt(0);
        unsigned nloc = b.st[0], nx = b.st[1];
        if (nloc == 0u) { xcd_barrier_complete(bar, b.x, nloc, nx); b.st[0] = nloc; b.st[1] = nx; }
        const unsigned old = xb_add(&bar[XB_XSUB(b.x)], 1u);
        const unsigned gen = old / nloc;
        if (old + 1u == (gen + 1u) * nloc) {
            __builtin_amdgcn_fence(__ATOMIC_RELEASE, "agent");
            asm volatile("s_waitcnt vmcnt(0)" ::: "memory");
            const unsigned og = xb_add(&bar[XB_TOP], 1u);
            const unsigned tg = og / nx;
            if (og + 1u == (tg + 1u) * nx) xb_add(&bar[XB_TOPGEN], 1u);
            else XB_SPIN(xb_ld(&bar[XB_TOPGEN]) == tg, bar);
            __builtin_amdgcn_fence(__ATOMIC_ACQUIRE, "agent");
            xb_add(&bar[XB_XGEN(b.x)], 1u);
            asm volatile("s_waitcnt vmcnt(0)" ::: "memory");
        } else {
            XB_SPIN(xb_ld(&bar[XB_XGEN(b.x)]) == gen, bar);
            __builtin_amdgcn_fence(__ATOMIC_ACQUIRE, "agent");
            asm volatile("s_waitcnt vmcnt(0)" ::: "memory");
        }
    }
    __syncthreads();
}


constexpr int NWAVES = 8;
constexpr int M = 16384, SEQ = 8192, D = 1024, FF = 4096, NPROJ = 2560, IN_W = 2472;
constexpr float EPS = 1e-6f;
constexpr int R_CQ = 0, R_CKV = 256, R_KR = 384, R_GA = 416, R_GB = 420;

constexpr size_t MiB = 1u << 20, KiB = 1u << 10;
constexpr size_t WS_CTL = 0, CTL_ZERO_BYTES = 1 * MiB;
constexpr size_t WS_WIN = 1 * MiB, WS_WQ = 11 * MiB, WS_WKV = 11 * MiB + 768 * KiB, WS_WOUT = 13 * MiB, WS_WUP = 17 * MiB, WS_WDN = 33 * MiB;
constexpr size_t WS_COS = 49 * MiB, WS_SIN = 50 * MiB;
constexpr size_t WS_RSQ = 51 * MiB, WS_RSKV = 51 * MiB + 64 * KiB, WS_BETA = 51 * MiB + 128 * KiB, WS_LOGA = 51 * MiB + 384 * KiB;
constexpr size_t WS_XN = 52 * MiB, WS_REST = 84 * MiB, WS_OPSX = 100 * MiB, WS_GG = 125 * MiB, WS_GQ = 141 * MiB, WS_GK = 157 * MiB, WS_GV = 173 * MiB;
constexpr size_t WS_Q = 189 * MiB, WS_K = 213 * MiB, WS_V = 237 * MiB, WS_END = 256 * MiB;
constexpr size_t WS_CAT = WS_GQ, WS_H = 125 * MiB, WS_OPS = 52 * MiB;
constexpr size_t WS_NQ = 52 * MiB, WS_NK = 68 * MiB, WS_NV = 100 * MiB, WS_ORAW = WS_GV, WS_MIXED = 189 * MiB, WS_F = 52 * MiB, WS_XN1 = WS_XN, WS_R3 = 84 * MiB;
constexpr size_t WS_CQN = 100 * MiB, WS_CKVN = 108 * MiB;
constexpr size_t WS_XCH = 253 * MiB;
constexpr int CW_BAR = 4096, CW_TMO = 0, CW_SEAM = 16384, SEAM_BANK = 64 * 64;

constexpr int RING_OFF = 0, RING_BYTES = 162816;
constexpr int LDSCTL_OFF = RING_BYTES, MISC_OFF = LDSCTL_OFF + 320;
constexpr int LDS_BYTES = 163840;

struct Args {
    const float* x; const int* pos; const float* mix_pre; const float* w_in; const float* conv_w; const float* a_log; const float* dt_bias; const float* gdn_norm;
    const float* q_norm; const float* w_q_up; const float* kv_norm; const float* w_kv_up; const float* w_out; const float* mix_post; const float* ffn_pre; const float* w_up; const float* w_down; const float* ffn_post;
    float* out; unsigned char* ws; int ph_lo, ph_hi;
};
struct Frame { LAS unsigned char* lds; int tid, lane, wave, vcu, G, gw, NGW; };

template <class MapF>
__device__ __forceinline__ void p0_transpose_item(const float* W, int K, int N, int nblk, bf16* WT, const float* kgain, int glim, int gmask, LAS float* scr, int item, int lane, MapF srcmap) {
    const int kb = item / nblk, nb = item % nblk, k0 = 64 * kb, n0 = 32 * nb;
    const int src = srcmap(n0 + (lane & 31));
    float wv[32];
#pragma unroll
    for (int i = 0; i < 32; ++i) { const int kk = 2 * i + (lane >> 5); wv[i] = src >= 0 ? W[(size_t)(k0 + kk) * N + src] : 0.f; }
#pragma unroll
    for (int i = 0; i < 32; ++i) { const int kk = 2 * i + (lane >> 5); float v = wv[i]; if (kgain && k0 + kk < glim) v *= kgain[(k0 + kk) & gmask]; scr[kk * 33 + (lane & 31)] = v; }
    LDS_WAIT(); asm volatile("" ::: "memory");
    const int c = lane & 7;
#pragma unroll
    for (int j = 0; j < 4; ++j) { const int n = (lane >> 3) + 8 * j; const LAS float* s = scr + (8 * c) * 33 + n;
        v4u o; o.x = pk2(s[0 * 33], s[1 * 33]); o.y = pk2(s[2 * 33], s[3 * 33]); o.z = pk2(s[4 * 33], s[5 * 33]); o.w = pk2(s[6 * 33], s[7 * 33]);
        *(GAS v4u*)(WT + (size_t)(n0 + n) * K + k0 + 8 * c) = o; }
    LDS_WAIT(); asm volatile("" ::: "memory");
}
struct MapId { __device__ __forceinline__ int operator()(int n) const { return n; } };
struct MapWin { __device__ __forceinline__ int operator()(int n) const { return n < 2048 ? n : (n < 2464 ? n + 8 : (n < 2472 ? n - 2464 + 2048 : -1)); } };

__device__ __forceinline__ void rms_row_to_bf16(int lane, const float* xrow, const float* gain, bf16* orow) {
    const GAS f32x4* xr = (const GAS f32x4*)xrow + lane; const f32x4* gr = (const f32x4*)gain + lane;
    f32x4 v[4]; float s = 0.f;
#pragma unroll
    for (int j = 0; j < 4; ++j) { v[j] = xr[64 * j]; s += (v[j].x * v[j].x + v[j].y * v[j].y) + (v[j].z * v[j].z + v[j].w * v[j].w); }
    const float rstd = rsqrtf(wave_sum(s, lane) * (1.f / D) + EPS);
    GAS unsigned long long* o8 = (GAS unsigned long long*)orow + lane;
#pragma unroll
    for (int j = 0; j < 4; ++j) { const f32x4 g = gr[64 * j]; o8[64 * j] = (unsigned long long)pk2(v[j].x * rstd * g.x, v[j].y * rstd * g.y) | ((unsigned long long)pk2(v[j].z * rstd * g.z, v[j].w * rstd * g.w) << 32); }
}
template <int R>
__device__ __forceinline__ void rms_rows_to_bf16(int lane, const float* xrow, size_t rstride, const float* gain, bf16* orow) {
    f32x4 v[R][4]; float s[R];
#pragma unroll
    for (int r = 0; r < R; ++r) { const GAS f32x4* xr = (const GAS f32x4*)(xrow + r * rstride) + lane; s[r] = 0.f;
#pragma unroll
        for (int j = 0; j < 4; ++j) v[r][j] = xr[64 * j]; }
#pragma unroll
    for (int r = 0; r < R; ++r)
#pragma unroll
        for (int j = 0; j < 4; ++j) s[r] += (v[r][j].x * v[r][j].x + v[r][j].y * v[r][j].y) + (v[r][j].z * v[r][j].z + v[r][j].w * v[r][j].w);
#pragma unroll
    for (int o = 1; o < 64; o <<= 1)
#pragma unroll
        for (int r = 0; r < R; ++r) s[r] += pg8::shx(s[r], lane, o);
    const f32x4* gr = (const f32x4*)gain + lane;
#pragma unroll
    for (int r = 0; r < R; ++r) { const float rstd = rsqrtf(s[r] * (1.f / D) + EPS); GAS unsigned long long* o8 = (GAS unsigned long long*)(orow + r * rstride) + lane;
#pragma unroll
        for (int j = 0; j < 4; ++j) { const f32x4 g = gr[64 * j]; o8[64 * j] = (unsigned long long)pk2(v[r][j].x * rstd * g.x, v[r][j].y * rstd * g.y) | ((unsigned long long)pk2(v[r][j].z * rstd * g.z, v[r][j].w * rstd * g.w) << 32); } }
}
__device__ __forceinline__ void resid_norm_row(int lane, const float* xi, const float* y, const float* g1, float* xo, const float* g2, bf16* xn) {
    const f32x4* yr = (const f32x4*)y + lane; const f32x4* xr = (const f32x4*)xi + lane; const f32x4* g1r = (const f32x4*)g1 + lane;
    f32x4 v[4]; float s = 0.f;
#pragma unroll
    for (int j = 0; j < 4; ++j) { v[j] = yr[64 * j]; s += (v[j].x * v[j].x + v[j].y * v[j].y) + (v[j].z * v[j].z + v[j].w * v[j].w); }
    const float r = rsqrtf(wave_sum(s, lane) * (1.f / D) + EPS);
    float s2 = 0.f;
#pragma unroll
    for (int j = 0; j < 4; ++j) { v[j] = xr[64 * j] + v[j] * r * g1r[64 * j]; s2 += (v[j].x * v[j].x + v[j].y * v[j].y) + (v[j].z * v[j].z + v[j].w * v[j].w); }
#pragma unroll
    for (int j = 0; j < 4; ++j) ((f32x4*)xo + lane)[64 * j] = v[j];
    if (g2) {
        const float r2 = rsqrtf(wave_sum(s2, lane) * (1.f / D) + EPS);
        unsigned long long* o8 = (unsigned long long*)xn + lane;
#pragma unroll
        for (int j = 0; j < 4; ++j) { const f32x4 g = ((const f32x4*)g2 + lane)[64 * j]; o8[64 * j] = (unsigned long long)pk2(v[j].x * r2 * g.x, v[j].y * r2 * g.y) | ((unsigned long long)pk2(v[j].z * r2 * g.z, v[j].w * r2 * g.w) << 32); }
    }
}
namespace att {
typedef __attribute__((ext_vector_type(8))) short bf16x8;
typedef __attribute__((ext_vector_type(4))) short s16x4;
typedef __attribute__((ext_vector_type(16))) float f32x16;
typedef __attribute__((ext_vector_type(4))) unsigned u32x4;
constexpr int QP = 768, KP = 768, VP = 512, OP = 1024, SEQL = 8192;
constexpr int NW = 8, QBLK = 32, QB = 256, KVBLK = 64;
constexpr int NSLOT = 4, KSLOT = 12288, VSLOT = 8192;
constexpr int LDS_K = 0, LDS_V = NSLOT * KSLOT, LDS_WS = LDS_V + NSLOT * VSLOT, LDS_OST = LDS_WS + NW * 64 * 4, LDS_BYTES = LDS_OST + NW * 4096;
__device__ __forceinline__ int crow(int r, int hi) { return (r & 3) + 8 * (r >> 2) + 4 * hi; }
__device__ __forceinline__ void glds16(const void* gsrc, unsigned lds_dst) { unsigned keep;
    asm volatile("s_mov_b32 %0, m0\n\ts_mov_b32 m0, %2\n\ts_nop 0\n\tglobal_load_lds_dwordx4 %1, off\n\ts_mov_b32 m0, %0" : "=&s"(keep) : "v"(gsrc), "s"(lds_dst) : "memory"); }
typedef float f32x2_t __attribute__((ext_vector_type(2))); typedef __bf16 bf16x2_t __attribute__((ext_vector_type(2)));
__device__ __forceinline__ unsigned cvtpk_s(float lo, float hi) { f32x2_t v = {lo, hi}; bf16x2_t b = __builtin_convertvector(v, bf16x2_t); return __builtin_bit_cast(unsigned, b); }
#define ATT_WAIT_BAR(N) asm volatile("s_waitcnt vmcnt(" #N ") lgkmcnt(0)\n\ts_barrier" ::: "memory")
typedef __attribute__((address_space(3))) const char* lds_cptr;

#define ATT_SBAR() __builtin_amdgcn_sched_barrier(0)
#define ATT_PIN(x) asm volatile("" : "+v"(x))
#define ATT_MFMA(a, b, c) __builtin_amdgcn_mfma_f32_32x32x16_bf16(a, b, c, 0, 0, 0)
#define ATT_THR 8.0f
typedef short v4i16_t __attribute__((ext_vector_type(4)));
__device__ __forceinline__ void kload2(bf16x8* kf, lds_cptr kp, int d0) { kf[2 * d0] = *(const __attribute__((address_space(3))) bf16x8*)(kp + d0 * 2048); kf[2 * d0 + 1] = *(const __attribute__((address_space(3))) bf16x8*)(kp + d0 * 2048 + 512); }
__device__ __forceinline__ s16x4 vtr(lds_cptr p) { return __builtin_bit_cast(s16x4, __builtin_amdgcn_ds_read_tr16_b64_v4i16((__attribute__((address_space(3))) v4i16_t*)p)); }
#define ATT_MX3(a, b, c) __builtin_fmaxf(__builtin_fmaxf((a), (b)), (c))
__device__ __forceinline__ float rowmax(const f32x16& p0, const f32x16& p1) {
    float a = ATT_MX3(p0[0], p0[1], p1[0]), b = ATT_MX3(p0[2], p0[3], p1[1]); a = ATT_MX3(a, p1[2], p1[3]);
#pragma unroll
    for (int r = 4; r < 16; r += 4) { a = ATT_MX3(a, p0[r], p0[r + 1]); b = ATT_MX3(b, p0[r + 2], p0[r + 3]); a = ATT_MX3(a, p1[r], p1[r + 1]); b = ATT_MX3(b, p1[r + 2], p1[r + 3]); }
    float m = __builtin_fmaxf(a, b); auto rr = __builtin_amdgcn_permlane32_swap(__float_as_uint(m), __float_as_uint(m), false, false);
    return __builtin_fmaxf(__uint_as_float(rr[0]), __uint_as_float(rr[1])); }

template <int AM>
__device__ __forceinline__ void attn_unit(int b, int h, int qb, const unsigned short* Q, const unsigned short* K, const unsigned short* V, unsigned short* O, const float* ctab, const float* stab, char* shm, int tid_in) {
    int tid_ = tid_in; asm volatile("" : "+v"(tid_));
    const int tid = tid_, lane = tid & 63, r32 = lane & 31, hi = lane >> 5; const int wid = __builtin_amdgcn_readfirstlane(tid >> 6);
    const long rowbase = (long)b * SEQL; const int q0 = qb * QB;
    const unsigned short* Qw = Q + (rowbase + q0 + wid * QBLK) * QP + h * 96;
    const unsigned short* Kh = K + rowbase * KP + h * 96; const unsigned short* Vh = V + rowbase * VP + h * 64;
    const unsigned lds0 = (unsigned)(uintptr_t)shm;
    __attribute__((address_space(3))) float* wsf = (__attribute__((address_space(3))) float*)(shm + LDS_WS) + wid * 64;
    const unsigned short* ksrc0 = Kh + (long)lane * KP + wid * 8;
    const unsigned short* ksrc1 = Kh + (long)lane * KP + (8 + (wid & 3)) * 8;
    const unsigned short* vsrc = Vh + (long)(16 * (wid & 3) + (lane >> 2)) * VP + (wid >> 2) * 32 + (lane & 3) * 8;
    const unsigned kdst0 = lds0 + LDS_K + wid * 1024, kdst1 = lds0 + LDS_K + (8 + (wid & 3)) * 1024, vdst = lds0 + LDS_V + wid * 1024;
    const bool two = wid < 4;
#define ATT_DMAK(t, s) do { glds16(ksrc0 + (long)(t) * KVBLK * KP, (unsigned)__builtin_amdgcn_readfirstlane(kdst0 + (s) * KSLOT)); \
        if (two) glds16(ksrc1 + (long)(t) * KVBLK * KP, (unsigned)__builtin_amdgcn_readfirstlane(kdst1 + (s) * KSLOT)); } while (0)
#define ATT_DMAV(t, s) glds16(vsrc + (long)(t) * KVBLK * VP, (unsigned)__builtin_amdgcn_readfirstlane(vdst + (s) * VSLOT))
    const lds_cptr vp0 = (lds_cptr)(shm + LDS_V) + ((lane >> 4) & 1) * 32 + (lane & 3) * 8 + (4 * hi + ((lane & 15) >> 2)) * 64;
    const lds_cptr kp0 = (lds_cptr)(shm + LDS_K) + hi * 1024 + r32 * 16;
    const int NT = (q0 + QB) / KVBLK;
    const int tvis = 4 * qb + (wid >> 1);
    ATT_DMAK(0, 0); ATT_DMAK(1, 1); ATT_DMAV(0, 0);
    bf16x8 qr[6];
#pragma unroll
    for (int d0 = 0; d0 < 6; ++d0) qr[d0] = *reinterpret_cast<const bf16x8*>(&Qw[(long)r32 * QP + d0 * 16 + hi * 8]);
    {
        const long mrow = rowbase + q0 + wid * QBLK + r32;
        const float* cp = ctab + mrow * 16 + 8 * hi; const float* sp = stab + mrow * 16 + 8 * hi;
        float c[8], s[8];
#pragma unroll
        for (int e = 0; e < 8; ++e) { c[e] = cp[e]; s[e] = sp[e]; }
        u32x4 a4 = __builtin_bit_cast(u32x4, qr[4]), a5 = __builtin_bit_cast(u32x4, qr[5]), n4, n5;
#pragma unroll
        for (int w = 0; w < 4; ++w) {
            const float x1l = __builtin_bit_cast(float, a4[w] << 16), x1h = __builtin_bit_cast(float, a4[w] & 0xffff0000u), x2l = __builtin_bit_cast(float, a5[w] << 16), x2h = __builtin_bit_cast(float, a5[w] & 0xffff0000u);
            n4[w] = cvtpk_s(x1l * c[2 * w] - x2l * s[2 * w], x1h * c[2 * w + 1] - x2h * s[2 * w + 1]);
            n5[w] = cvtpk_s(x2l * c[2 * w] + x1l * s[2 * w], x2h * c[2 * w + 1] + x1h * s[2 * w + 1]); }
        qr[4] = __builtin_bit_cast(bf16x8, n4); qr[5] = __builtin_bit_cast(bf16x8, n5);
    }
#pragma unroll
    for (int d0 = 0; d0 < 6; ++d0) ATT_PIN(qr[d0]);
    ATT_DMAK(2, 2); ATT_DMAV(1, 1); ATT_DMAK(3, 3); ATT_DMAV(2, 2);
    float mhat = 0.f, l_reg = 0.f; f32x16 o[2]; o[0] = f32x16{}; o[1] = f32x16{};
    f32x16 negm16 = f32x16{}; ATT_PIN(negm16);
    bool resc = false;
    f32x16 pA0, pA1, pB0, pB1; bf16x8 kf[12]; s16x4 vlo[8], vhi[8]; u32x4 pw0, pw1, pw2, pw3;
#define ATT_RESC() do { if (resc) { const int hi_ = lane_now() >> 5; _Pragma("unroll") for (int r = 0; r < 16; ++r) { const float f_ = wsf[crow(r, hi_)]; o[0][r] *= f_; o[1][r] *= f_; } } } while (0)
    if (two) ATT_WAIT_BAR(6); else ATT_WAIT_BAR(4);
    _Pragma("unroll") for (int d0 = 0; d0 < 6; ++d0) kload2(kf, kp0, d0);
    pA0 = ATT_MFMA(kf[0], qr[0], negm16); pA1 = ATT_MFMA(kf[1], qr[0], negm16);
    _Pragma("unroll") for (int d0 = 1; d0 < 6; ++d0) { pA0 = ATT_MFMA(kf[2 * d0], qr[d0], pA0); pA1 = ATT_MFMA(kf[2 * d0 + 1], qr[d0], pA1); }
    { const float rm = rowmax(pA0, pA1); mhat = rm;
#pragma unroll
      for (int r = 0; r < 16; ++r) { pA0[r] = __builtin_amdgcn_exp2f(pA0[r] - rm); pA1[r] = __builtin_amdgcn_exp2f(pA1[r] - rm); }
#pragma unroll
      for (int r = 0; r < 16; ++r) negm16[r] = -rm;
      ATT_PIN(negm16); }
    if (two) ATT_WAIT_BAR(4); else ATT_WAIT_BAR(3);
    _Pragma("unroll") for (int d0 = 0; d0 < 6; ++d0) kload2(kf, kp0 + KSLOT, d0);
#define ATT_PKW(P, i) cvtpk_s(P[i], P[(i) + 1])
#define ATT_PAF(k) __builtin_bit_cast(bf16x8, pw##k)
#define ATT_VFR(i) (bf16x8){vlo[i][0], vlo[i][1], vlo[i][2], vlo[i][3], vhi[i][0], vhi[i][1], vhi[i][2], vhi[i][3]}
#define ATT_VRD(i) do { vlo[i] = vtr(vp_ + (((i) >> 2) * 4096 + ((i) & 3) * 1024)); vhi[i] = vtr(vp_ + (((i) >> 2) * 4096 + ((i) & 3) * 1024 + 512)); ATT_SBAR(); } while (0)
#define ATT_KRD(G, d0) do { if (G) { kload2(kf, kn_, d0); ATT_SBAR(); } } while (0)
#define ATT_GAPA(MF, ADDS, PK, PW) do { MF; ADDS; PK; ATT_PIN(PW); ATT_PIN(sacc); ATT_SBAR(); } while (0)
#define ATT_GAPB(MF, X, i) do { MF; X[i] = __builtin_amdgcn_exp2f(X[i]); X[(i) + 1] = __builtin_amdgcn_exp2f(X[(i) + 1]); X[(i) + 2] = __builtin_amdgcn_exp2f(X[(i) + 2]); X[(i) + 3] = __builtin_amdgcn_exp2f(X[(i) + 3]); ATT_PIN(X); ATT_SBAR(); } while (0)
#define ATT_STEP(C0, C1, P0, P1, t, MASK, GK, GV, GL) do { ATT_SBAR(); \
    const lds_cptr vp_ = vp0 + (((t) - 1) & 3) * VSLOT; const lds_cptr kn_ = kp0 + (((t) + 1) & 3) * KSLOT; \
    float sacc = P0[0] + P0[1]; \
    ATT_GAPA(C0 = ATT_MFMA(kf[0], qr[0], negm16), sacc += P0[2]; sacc += P0[3]; sacc += P0[4],    pw0[0] = ATT_PKW(P0, 0), pw0); \
    ATT_GAPA(C1 = ATT_MFMA(kf[1], qr[0], negm16), sacc += P0[5]; sacc += P0[6]; sacc += P0[7],    pw0[1] = ATT_PKW(P0, 2), pw0); \
    ATT_GAPA(C0 = ATT_MFMA(kf[2], qr[1], C0),     sacc += P0[8]; sacc += P0[9]; sacc += P0[10],   pw0[2] = ATT_PKW(P0, 4), pw0); \
    ATT_GAPA(C1 = ATT_MFMA(kf[3], qr[1], C1),     sacc += P0[11]; sacc += P0[12]; sacc += P0[13], pw0[3] = ATT_PKW(P0, 6), pw0); \
    ATT_GAPA(C0 = ATT_MFMA(kf[4], qr[2], C0),     sacc += P0[14]; sacc += P0[15]; sacc += P1[0],  pw1[0] = ATT_PKW(P0, 8), pw1); \
    ATT_GAPA(C1 = ATT_MFMA(kf[5], qr[2], C1),     sacc += P1[1]; sacc += P1[2]; sacc += P1[3],    pw1[1] = ATT_PKW(P0, 10), pw1); \
    ATT_GAPA(C0 = ATT_MFMA(kf[6], qr[3], C0),     sacc += P1[4]; sacc += P1[5]; sacc += P1[6],    pw1[2] = ATT_PKW(P0, 12); pw2[0] = ATT_PKW(P1, 0), pw1); \
    ATT_GAPA(C1 = ATT_MFMA(kf[7], qr[3], C1),     sacc += P1[7]; sacc += P1[8]; sacc += P1[9],    pw1[3] = ATT_PKW(P0, 14); pw2[1] = ATT_PKW(P1, 2), pw1); \
    ATT_VRD(0); ATT_GAPA(C0 = ATT_MFMA(kf[8], qr[4], C0),   sacc += P1[10]; sacc += P1[11],  pw2[2] = ATT_PKW(P1, 4); pw2[3] = ATT_PKW(P1, 6), pw2); \
    ATT_VRD(4); ATT_GAPA(C1 = ATT_MFMA(kf[9], qr[4], C1),   sacc += P1[12]; sacc += P1[13],  pw3[0] = ATT_PKW(P1, 8); pw3[1] = ATT_PKW(P1, 10), pw3); \
    ATT_VRD(1); ATT_GAPA(C0 = ATT_MFMA(kf[10], qr[5], C0),  sacc += P1[14],                  pw3[2] = ATT_PKW(P1, 12), pw3); \
    ATT_VRD(5); ATT_GAPA(C1 = ATT_MFMA(kf[11], qr[5], C1),  sacc += P1[15],                  pw3[3] = ATT_PKW(P1, 14), pw3); \
    l_reg += sacc; \
    if (GK) ATT_DMAK((t) + 3, ((t) + 3) & 3); if (GV) ATT_DMAV((t) + 2, ((t) + 2) & 3); \
    if (MASK) { if ((t) > tvis) { _Pragma("unroll") for (int r = 0; r < 16; ++r) { C0[r] = -INFINITY; C1[r] = -INFINITY; } } } \
    { const float rm = rowmax(C0, C1); resc = false;                                                   \
      if (__builtin_expect(__any(rm > ATT_THR), 0)) { const float dl = __builtin_fmaxf(rm, 0.f); mhat += dl;                                \
          const float f = __builtin_amdgcn_exp2f(-dl); l_reg *= f; { const int ln_ = lane_now(); if (ln_ < 32) wsf[ln_] = f; } resc = true; \
          _Pragma("unroll") for (int r = 0; r < 16; ++r) { C0[r] -= dl; C1[r] -= dl; negm16[r] = -mhat; } ATT_PIN(negm16); } } \
    ATT_SBAR(); \
    ATT_VRD(2);                 ATT_GAPB(o[0] = ATT_MFMA(ATT_PAF(0), ATT_VFR(0), o[0]), C0, 0); \
    ATT_VRD(6); ATT_KRD(GL, 0); ATT_GAPB(o[1] = ATT_MFMA(ATT_PAF(0), ATT_VFR(4), o[1]), C0, 4); \
    ATT_VRD(3); ATT_KRD(GL, 1); ATT_GAPB(o[0] = ATT_MFMA(ATT_PAF(1), ATT_VFR(1), o[0]), C0, 8); \
    ATT_VRD(7); ATT_KRD(GL, 2); ATT_GAPB(o[1] = ATT_MFMA(ATT_PAF(1), ATT_VFR(5), o[1]), C0, 12); \
                ATT_KRD(GL, 3); ATT_GAPB(o[0] = ATT_MFMA(ATT_PAF(2), ATT_VFR(2), o[0]), C1, 0); \
                ATT_KRD(GL, 4); ATT_GAPB(o[1] = ATT_MFMA(ATT_PAF(2), ATT_VFR(6), o[1]), C1, 4); \
                ATT_KRD(GL, 5); ATT_GAPB(o[0] = ATT_MFMA(ATT_PAF(3), ATT_VFR(3), o[0]), C1, 8); \
                                ATT_GAPB(o[1] = ATT_MFMA(ATT_PAF(3), ATT_VFR(7), o[1]), C1, 12); \
    } while (0)
#define ATT_ENDW(tt) do { if ((tt) + 3 < NT) { if (two) ATT_WAIT_BAR(4); else ATT_WAIT_BAR(3); } else ATT_WAIT_BAR(0); } while (0)
    int t = 1;
    for (; t + 5 < NT; t += 2) {
        ATT_STEP(pB0, pB1, pA0, pA1, t, false, true, true, true);     if (two) ATT_WAIT_BAR(4); else ATT_WAIT_BAR(3); ATT_RESC();
        ATT_STEP(pA0, pA1, pB0, pB1, t + 1, false, true, true, true); if (two) ATT_WAIT_BAR(4); else ATT_WAIT_BAR(3); ATT_RESC();
    }
    for (; t + 1 < NT; t += 2) {
        ATT_STEP(pB0, pB1, pA0, pA1, t, true, (t + 3 < NT), (t + 2 < NT), (t + 1 < NT));     ATT_ENDW(t);     ATT_RESC();
        ATT_STEP(pA0, pA1, pB0, pB1, t + 1, true, (t + 4 < NT), (t + 3 < NT), (t + 2 < NT)); ATT_ENDW(t + 1); ATT_RESC();
    }
    ATT_STEP(pB0, pB1, pA0, pA1, NT - 1, true, false, false, false); ATT_RESC();
    { float sacc = pB0[0] + pB0[1];
#pragma unroll
      for (int r = 2; r < 16; ++r) sacc += pB0[r];
#pragma unroll
      for (int r = 0; r < 16; ++r) sacc += pB1[r];
      l_reg += sacc;
      pw0 = (u32x4){ATT_PKW(pB0, 0), ATT_PKW(pB0, 2), ATT_PKW(pB0, 4), ATT_PKW(pB0, 6)}; pw1 = (u32x4){ATT_PKW(pB0, 8), ATT_PKW(pB0, 10), ATT_PKW(pB0, 12), ATT_PKW(pB0, 14)};
      pw2 = (u32x4){ATT_PKW(pB1, 0), ATT_PKW(pB1, 2), ATT_PKW(pB1, 4), ATT_PKW(pB1, 6)}; pw3 = (u32x4){ATT_PKW(pB1, 8), ATT_PKW(pB1, 10), ATT_PKW(pB1, 12), ATT_PKW(pB1, 14)};
      const lds_cptr vp_ = vp0 + ((NT - 1) & 3) * VSLOT; _Pragma("unroll") for (int i = 0; i < 8; ++i) ATT_VRD(i);
      o[0] = ATT_MFMA(ATT_PAF(0), ATT_VFR(0), o[0]); o[1] = ATT_MFMA(ATT_PAF(0), ATT_VFR(4), o[1]); o[0] = ATT_MFMA(ATT_PAF(1), ATT_VFR(1), o[0]); o[1] = ATT_MFMA(ATT_PAF(1), ATT_VFR(5), o[1]);
      o[0] = ATT_MFMA(ATT_PAF(2), ATT_VFR(2), o[0]); o[1] = ATT_MFMA(ATT_PAF(2), ATT_VFR(6), o[1]); o[0] = ATT_MFMA(ATT_PAF(3), ATT_VFR(3), o[0]); o[1] = ATT_MFMA(ATT_PAF(3), ATT_VFR(7), o[1]); }
    { auto rr = __builtin_amdgcn_permlane32_swap(__float_as_uint(l_reg), __float_as_uint(l_reg), false, false); l_reg = __uint_as_float(rr[0]) + __uint_as_float(rr[1]); }
    if (hi == 0) wsf[32 + r32] = l_reg;
    asm volatile("s_waitcnt lgkmcnt(0)" ::: "memory");
    float rli[16];
#pragma unroll
    for (int r = 0; r < 16; ++r) rli[r] = __builtin_amdgcn_rcpf(wsf[32 + crow(r, hi)]);
    unsigned short* Ow = O + (rowbase + q0 + wid * QBLK) * OP + 512 + h * 64;
    { __attribute__((address_space(3))) unsigned short* stg = (__attribute__((address_space(3))) unsigned short*)(shm + LDS_OST) + wid * 2048;
#pragma unroll
      for (int r = 0; r < 16; ++r) { const int orow = crow(r, hi);
#pragma unroll
          for (int d0 = 0; d0 < 2; ++d0) stg[orow * 64 + d0 * 32 + r32] = (unsigned short)(cvtpk_s(o[d0][r] * rli[r], 0.f) & 0xffffu); }
      asm volatile("s_waitcnt lgkmcnt(0)" ::: "memory");
#pragma unroll
      for (int i = 0; i < 4; ++i) { const int row = i * 8 + (lane >> 3), ch = lane & 7; const u32x4 v = *(const __attribute__((address_space(3))) u32x4*)(stg + row * 64 + ch * 8); if (!(AM & 1)) *(u32x4*)(Ow + (long)row * OP + ch * 8) = v; else asm volatile("" :: "v"(v)); } }
    asm volatile("s_waitcnt lgkmcnt(0)\n\ts_barrier" ::: "memory");
#undef ATT_DMAK
#undef ATT_DMAV
#undef ATT_RESC
#undef ATT_PKW
#undef ATT_PAF
#undef ATT_VFR
#undef ATT_VRD
#undef ATT_KRD
#undef ATT_GAPA
#undef ATT_GAPB
#undef ATT_STEP
#undef ATT_ENDW
}
#undef ATT_WAIT_BAR
}
#ifndef PROBE_DUP
#define PROBE_DUP -1
#endif
namespace gdn {
typedef __attribute__((ext_vector_type(8))) short bf16x8;
typedef __attribute__((ext_vector_type(16))) float f32x16;
typedef __attribute__((ext_vector_type(4))) unsigned u32x4;
typedef __attribute__((ext_vector_type(4))) float f32x4;
#define GLAS __attribute__((address_space(3)))
constexpr int UNIT_BYTES = 74752, OFF_W = 0, OFF_Q = 16384, OFF_KT = 32768, OFF_P = 49152, OFF_U = 57344, OFF_SC = 73728, DMA_BYTES = 57344;
constexpr int L_KN = 0, L_QN = 17408, L_VBT = 34816, L_KBGT = 53248, L_A = 71680, L_T = 89088, L_SC = 98304, L_A10B = 99328, L_T00T = 101888, L_RAW = 104448, RAW_ARR = 17408, L_CW = L_RAW + 3 * RAW_ARR, L_END = L_CW + 6144, L_PRE = 163328;
constexpr int A10P = 40;
constexpr int KNP = 136, VTP = 72, AP = 68, TP = 72;
__device__ __forceinline__ int crow(int r, int hi) { return (r & 3) + 8 * (r >> 2) + 4 * hi; }
__device__ __forceinline__ unsigned cvtpk(float lo, float hi) { typedef float f2 __attribute__((ext_vector_type(2))); typedef __bf16 b2 __attribute__((ext_vector_type(2))); f2 v = {lo, hi}; b2 b = __builtin_convertvector(v, b2); return __builtin_bit_cast(unsigned, b); }
__device__ __forceinline__ bf16x8 pack8(const f32x16& x, int o) { u32x4 w = {cvtpk(x[o], x[o + 1]), cvtpk(x[o + 2], x[o + 3]), cvtpk(x[o + 4], x[o + 5]), cvtpk(x[o + 6], x[o + 7])}; return __builtin_bit_cast(bf16x8, w); }
__device__ __forceinline__ float b2f(unsigned short b) { return __builtin_bit_cast(float, (unsigned)b << 16); }
__device__ __forceinline__ void glds16(const void* gsrc, unsigned lds_dst) { unsigned keep;
    asm volatile("s_mov_b32 %0, m0\n\ts_mov_b32 m0, %2\n\ts_nop 0\n\tglobal_load_lds_dwordx4 %1, off\n\ts_mov_b32 m0, %0" : "=&s"(keep) : "v"(gsrc), "s"(lds_dst) : "memory"); }

__device__ __forceinline__ void glds4(const void* gsrc, unsigned lds_dst) { unsigned keep;
    asm volatile("s_mov_b32 %0, m0\n\ts_mov_b32 m0, %2\n\ts_nop 0\n\tglobal_load_lds_dword %1, off\n\ts_mov_b32 m0, %0" : "=&s"(keep) : "v"(gsrc), "s"(lds_dst) : "memory"); }
__device__ __forceinline__ void prep_issue_raw(int u, const unsigned short* GQ, const unsigned short* GK, const unsigned short* GV, char* shm, int tid) {
    const int lane = tid & 63, wave = __builtin_amdgcn_readfirstlane(tid >> 6);
    const int bh = u >> 7, n = u & 127, b = bh >> 2, h = bh & 3; const long m0 = (long)b * 8192 + n * 64;
    const unsigned lds0 = (unsigned)(uintptr_t)shm + L_RAW;
#pragma unroll
    for (int x = 0; x < 7; ++x) { const int piece = wave + 8 * x;
        if (piece < 51) { const int arr = piece / 17, p = piece % 17; const unsigned short* src = (arr == 0 ? GQ : (arr == 1 ? GK : GV)) + (m0 - 3 + 4 * p + (lane >> 4)) * 512 + h * 128 + 8 * (lane & 15);
            glds16(src, (unsigned)__builtin_amdgcn_readfirstlane(lds0 + arr * RAW_ARR + p * 1024)); } }
}
__device__ __forceinline__ void prep_issue_pre(int u, const float* beta, const float* loga, char* shm, int tid) {
    const int lane = tid & 63, wave = __builtin_amdgcn_readfirstlane(tid >> 6);
    const int bh = u >> 7, n = u & 127, b = bh >> 2, h = bh & 3; const long m0 = (long)b * 8192 + n * 64;
    if (wave == 7) { glds4(beta + (m0 + lane) * 4 + h, (unsigned)__builtin_amdgcn_readfirstlane((unsigned)(uintptr_t)shm + L_PRE)); glds4(loga + (m0 + lane) * 4 + h, (unsigned)__builtin_amdgcn_readfirstlane((unsigned)(uintptr_t)shm + L_PRE + 256)); }
}
__device__ __forceinline__ void prep_unit(int u, const unsigned short* GQ, const unsigned short* GK, const unsigned short* GV, const float* beta, const float* loga, const float* cw, unsigned char* ops, char* shm, int tid_in, int u_next) {
    int tid_ = tid_in; asm volatile("" : "+v"(tid_));
    const int tid = tid_, lane = tid & 63, wave = __builtin_amdgcn_readfirstlane(tid >> 6), r32 = lane & 31, hi = lane >> 5;
    const int bh = u >> 7, n = u & 127, b = bh >> 2, h = bh & 3, t0 = n * 64; const long m0 = (long)b * 8192 + t0;
    unsigned char* ub = ops + (size_t)u * UNIT_BYTES;
    GLAS unsigned short* Kn = (GLAS unsigned short*)(shm + L_KN); GLAS unsigned short* Qn = (GLAS unsigned short*)(shm + L_QN);
    GLAS unsigned short* VBt = (GLAS unsigned short*)(shm + L_VBT); GLAS unsigned short* KBGt = (GLAS unsigned short*)(shm + L_KBGT);
    GLAS float* Am = (GLAS float*)(shm + L_A); GLAS unsigned short* Tb = (GLAS unsigned short*)(shm + L_T);
    GLAS float* sc_g = (GLAS float*)(shm + L_SC); GLAS float* sc_beta = sc_g + 64; GLAS float* sc_eg = sc_g + 128; GLAS float* sc_ekl = sc_g + 192;
    GLAS unsigned short* A10b = (GLAS unsigned short*)(shm + L_A10B); GLAS unsigned short* T00t = (GLAS unsigned short*)(shm + L_T00T);
    asm volatile("s_waitcnt vmcnt(0)" ::: "memory"); __syncthreads();
    for (int rep0_ = 0; rep0_ < (PROBE_DUP == 205 ? 2 : 1); ++rep0_)
    if (wave == 0) {
        const float bt = beta[(m0 + lane) * 4 + h]; float g = loga[(m0 + lane) * 4 + h];
#pragma unroll
        for (int o = 1; o < 64; o <<= 1) { const float x = __builtin_bit_cast(float, __builtin_amdgcn_ds_bpermute((lane - o) << 2, __builtin_bit_cast(int, g))); if (lane >= o) g += x; }
        const float gl = __builtin_bit_cast(float, __builtin_amdgcn_readlane(__builtin_bit_cast(int, g), 63));
        sc_g[lane] = g; sc_beta[lane] = bt; sc_eg[lane] = __expf(g); sc_ekl[lane] = __expf(gl - g);
        if (lane == 63) *(float*)(ub + OFF_SC) = __expf(g);
    }
    const int tok = tid >> 3, part = tid & 7, c0 = h * 128 + 16 * part;
    float q[16], k[16], v[16];
#pragma unroll
    for (int c = 0; c < 16; ++c) { q[c] = 0.f; k[c] = 0.f; v[c] = 0.f; }
    {
        const GLAS unsigned short* rawq = (const GLAS unsigned short*)(shm + L_RAW) + tok * 128 + 16 * part;
#pragma unroll
        for (int j = 0; j < 4; ++j) {
            const bool ok = t0 + tok - 3 + j >= 0;
            const u32x4 q0 = *(const GLAS u32x4*)(rawq + j * 128), q1 = *(const GLAS u32x4*)(rawq + j * 128 + 8);
            const u32x4 k0 = *(const GLAS u32x4*)(rawq + RAW_ARR / 2 + j * 128), k1 = *(const GLAS u32x4*)(rawq + RAW_ARR / 2 + j * 128 + 8);
            const u32x4 v0 = *(const GLAS u32x4*)(rawq + RAW_ARR + j * 128), v1 = *(const GLAS u32x4*)(rawq + RAW_ARR + j * 128 + 8);
            const GLAS float* wq = (const GLAS float*)(shm + L_CW) + j * 384 + 16 * part; const GLAS float* wk = wq + 128; const GLAS float* wv = wq + 256;
#pragma unroll
            for (int c4 = 0; c4 < 4; ++c4) {
                const f32x4 wq4 = *(const GLAS f32x4*)(wq + 4 * c4), wk4 = *(const GLAS f32x4*)(wk + 4 * c4), wv4 = *(const GLAS f32x4*)(wv + 4 * c4);
#pragma unroll
                for (int e = 0; e < 4; ++e) { const int c = 4 * c4 + e;
                    unsigned qw = c < 8 ? q0[c >> 1] : q1[(c - 8) >> 1], kw = c < 8 ? k0[c >> 1] : k1[(c - 8) >> 1], vw = c < 8 ? v0[c >> 1] : v1[(c - 8) >> 1];
                    qw = ok ? qw : 0u; kw = ok ? kw : 0u; vw = ok ? vw : 0u;
                    const float qv = __builtin_bit_cast(float, (c & 1) ? (qw & 0xffff0000u) : (qw << 16)), kv = __builtin_bit_cast(float, (c & 1) ? (kw & 0xffff0000u) : (kw << 16)), vv = __builtin_bit_cast(float, (c & 1) ? (vw & 0xffff0000u) : (vw << 16));
                    q[c] += wq4[e] * qv; k[c] += wk4[e] * kv; v[c] += wv4[e] * vv; }
            }
        }
    }
    float sq = 0.f, sk = 0.f;
#pragma unroll
    for (int c = 0; c < 16; ++c) { q[c] = q[c] * __builtin_amdgcn_rcpf(1.f + __expf(-q[c])); k[c] = k[c] * __builtin_amdgcn_rcpf(1.f + __expf(-k[c])); v[c] = v[c] * __builtin_amdgcn_rcpf(1.f + __expf(-v[c])); sq += q[c] * q[c]; sk += k[c] * k[c]; }
#pragma unroll
    for (int o = 1; o < 8; o <<= 1) { sq += __builtin_bit_cast(float, __builtin_amdgcn_ds_bpermute((lane ^ o) << 2, __builtin_bit_cast(int, sq))); sk += __builtin_bit_cast(float, __builtin_amdgcn_ds_bpermute((lane ^ o) << 2, __builtin_bit_cast(int, sk))); }
    __syncthreads();
    if (u_next >= 0) prep_issue_raw(u_next, GQ, GK, GV, shm, tid);
    {
        const float rq = rsqrtf(sq + 1e-6f) * 0.08838834764831845f, rk = rsqrtf(sk + 1e-6f), bt = sc_beta[tok], eg = sc_eg[tok];
        u32x4 w0, w1;
        w0 = (u32x4){cvtpk(k[0] * rk, k[1] * rk), cvtpk(k[2] * rk, k[3] * rk), cvtpk(k[4] * rk, k[5] * rk), cvtpk(k[6] * rk, k[7] * rk)};
        w1 = (u32x4){cvtpk(k[8] * rk, k[9] * rk), cvtpk(k[10] * rk, k[11] * rk), cvtpk(k[12] * rk, k[13] * rk), cvtpk(k[14] * rk, k[15] * rk)};
        *(GLAS u32x4*)(Kn + tok * KNP + 16 * part) = w0; *(GLAS u32x4*)(Kn + tok * KNP + 16 * part + 8) = w1;
        w0 = (u32x4){cvtpk(q[0] * rq, q[1] * rq), cvtpk(q[2] * rq, q[3] * rq), cvtpk(q[4] * rq, q[5] * rq), cvtpk(q[6] * rq, q[7] * rq)};
        w1 = (u32x4){cvtpk(q[8] * rq, q[9] * rq), cvtpk(q[10] * rq, q[11] * rq), cvtpk(q[12] * rq, q[13] * rq), cvtpk(q[14] * rq, q[15] * rq)};
        *(GLAS u32x4*)(Qn + tok * KNP + 16 * part) = w0; *(GLAS u32x4*)(Qn + tok * KNP + 16 * part + 8) = w1;
        const int ptok = tok ^ (8 * part);
#pragma unroll
        for (int c = 0; c < 16; ++c) { VBt[(16 * part + c) * VTP + ptok] = (unsigned short)(cvtpk(v[c] * bt, 0.f) & 0xffffu); KBGt[(16 * part + c) * VTP + ptok] = (unsigned short)(cvtpk(k[c] * rk * bt * eg, 0.f) & 0xffffu); }
        const float qs = rq * eg; const int f = (((tok >> 5) * 4 + (part >> 1)) * 2 + (part & 1));
        const u32x4 f0 = {cvtpk(q[0] * qs, q[1] * qs), cvtpk(q[2] * qs, q[3] * qs), cvtpk(q[8] * qs, q[9] * qs), cvtpk(q[10] * qs, q[11] * qs)};
        const u32x4 f1 = {cvtpk(q[4] * qs, q[5] * qs), cvtpk(q[6] * qs, q[7] * qs), cvtpk(q[12] * qs, q[13] * qs), cvtpk(q[14] * qs, q[15] * qs)};
        *(u32x4*)(ub + OFF_Q + f * 1024 + (tok & 31) * 16) = f0; *(u32x4*)(ub + OFF_Q + f * 1024 + ((tok & 31) + 32) * 16) = f1;
    }
    __syncthreads();
    {
        const int bw = wave & 3, ba = bw >> 1, bb = bw & 1;
        const bool isP = wave >= 4;
        const bool skip = isP ? (ba == 1 && bb == 0) : (ba == 0 && bb == 1);
        if (!skip) {
            const GLAS unsigned short* Ar = Kn + (32 * ba + r32) * KNP + 8 * hi; const GLAS unsigned short* Br = (isP ? Qn : Kn) + (32 * bb + r32) * KNP + 8 * hi;
            f32x16 acc = f32x16{};
#pragma unroll
            for (int s = 0; s < 8; ++s) acc = __builtin_amdgcn_mfma_f32_32x32x16_bf16(*(const GLAS bf16x8*)(Ar + 16 * s), *(const GLAS bf16x8*)(Br + 16 * s), acc, 0, 0, 0);
            const int col = 32 * bb + r32; const float gcol = sc_g[col];
            if (!isP) {
#pragma unroll
                for (int r = 0; r < 16; ++r) { const int i = 32 * ba + crow(r, hi); const float av = i > col ? sc_beta[i] * acc[r] * __expf(sc_g[i] - gcol) : 0.f; Am[i * AP + col] = av;
                    if (ba == 1 && bb == 0) A10b[crow(r, hi) * A10P + col] = (unsigned short)(cvtpk(av, 0.f) & 0xffffu); }
            } else {
#pragma unroll
                for (int r = 0; r < 16; ++r) { const int j = 32 * ba + crow(r, hi); acc[r] = col >= j ? acc[r] * __expf(gcol - sc_g[j]) : 0.f; }
                const int fb = (bb * 2 + ba) * 2;
                *(bf16x8*)(ub + OFF_P + fb * 1024 + lane * 16) = pack8(acc, 0); *(bf16x8*)(ub + OFF_P + (fb + 1) * 1024 + lane * 16) = pack8(acc, 8);
            }
        }
#pragma unroll
        for (int x = 0; x < 2; ++x) {
            const int item = tid + 512 * x, f = item >> 6, ln = item & 63, dk = 32 * (f >> 2) + (ln & 31), jb0 = 32 * ((f >> 1) & 1) + 16 * (f & 1) + 4 * (ln >> 5);
            float e[8];
#pragma unroll
            for (int j = 0; j < 8; ++j) { const int tk = jb0 + (j & 3) + 8 * (j >> 2); e[j] = b2f(Kn[tk * KNP + dk]) * sc_ekl[tk]; }
            const u32x4 w = {cvtpk(e[0], e[1]), cvtpk(e[2], e[3]), cvtpk(e[4], e[5]), cvtpk(e[6], e[7])};
            *(u32x4*)(ub + OFF_KT + f * 1024 + ln * 16) = w;
        }
    }
    __syncthreads();
    for (int rep3_ = 0; rep3_ < (PROBE_DUP == 203 ? 2 : 1); ++rep3_) {
    if (wave == 0) {
        const int blk = hi, c = r32; const GLAS float* Ab = Am + (32 * blk) * AP + 32 * blk;
        float Tc[32];
#pragma unroll
        for (int i = 0; i < 32; ++i) {
            float s0 = (i == c) ? 1.f : 0.f, s1 = 0.f, s2 = 0.f, s3 = 0.f;
#pragma unroll
            for (int j4 = 0; j4 < (i + 3) / 4; ++j4) { const f32x4 a4 = *(const GLAS f32x4*)(Ab + i * AP + 4 * j4);
                if (4 * j4 + 0 < i) s0 -= a4[0] * Tc[4 * j4 + 0]; if (4 * j4 + 1 < i) s1 -= a4[1] * Tc[4 * j4 + 1]; if (4 * j4 + 2 < i) s2 -= a4[2] * Tc[4 * j4 + 2]; if (4 * j4 + 3 < i) s3 -= a4[3] * Tc[4 * j4 + 3]; }
            Tc[i] = (s0 + s1) + (s2 + s3);
            Tb[(32 * blk + i) * TP + 32 * blk + c] = (unsigned short)(cvtpk(Tc[i], 0.f) & 0xffffu);
            if (blk == 1) Tb[i * TP + 32 + c] = 0;
        }
        if (blk == 0) {
#pragma unroll
            for (int x = 0; x < 4; ++x) { const u32x4 w = {cvtpk(Tc[8 * x], Tc[8 * x + 1]), cvtpk(Tc[8 * x + 2], Tc[8 * x + 3]), cvtpk(Tc[8 * x + 4], Tc[8 * x + 5]), cvtpk(Tc[8 * x + 6], Tc[8 * x + 7])}; *(GLAS u32x4*)(T00t + c * A10P + 8 * x) = w; }
        }
        asm volatile("s_waitcnt lgkmcnt(0)" ::: "memory");
        f32x16 X = f32x16{};
#pragma unroll
        for (int s = 0; s < 2; ++s) X = __builtin_amdgcn_mfma_f32_32x32x16_bf16(*(const GLAS bf16x8*)(A10b + r32 * A10P + 16 * s + 8 * hi), *(const GLAS bf16x8*)(T00t + r32 * A10P + 16 * s + 8 * hi), X, 0, 0, 0);
        f32x16 Y = f32x16{};
#pragma unroll
        for (int s = 0; s < 2; ++s) {
            typedef __attribute__((ext_vector_type(2))) unsigned u32x2;
            const GLAS unsigned short* tr = Tb + (32 + r32) * TP + 32 + 16 * s + 4 * hi;
            const u32x2 lo2 = *(const GLAS u32x2*)tr, hi2 = *(const GLAS u32x2*)(tr + 8);
            const u32x4 aw = {lo2[0], lo2[1], hi2[0], hi2[1]};
            Y = __builtin_amdgcn_mfma_f32_32x32x16_bf16(__builtin_bit_cast(bf16x8, aw), pack8(X, 8 * s), Y, 0, 0, 0); }
#pragma unroll
        for (int r = 0; r < 16; ++r) Tb[(32 + crow(r, hi)) * TP + r32] = (unsigned short)(cvtpk(-Y[r], 0.f) & 0xffffu);
    }
    __syncthreads();
    }
    {
        const int ib = wave >> 2, dvb = wave & 3;
        const GLAS unsigned short* Ar = Tb + (32 * ib + r32) * TP + 8 * hi; const GLAS unsigned short* Br = VBt + (32 * dvb + r32) * VTP; const int px = (2 * dvb + (r32 >> 4)) & 7;
        f32x16 acc = f32x16{};
#pragma unroll
        for (int s = 0; s < 4; ++s) acc = __builtin_amdgcn_mfma_f32_32x32x16_bf16(*(const GLAS bf16x8*)(Ar + 16 * s), *(const GLAS bf16x8*)(Br + 8 * ((2 * s + hi) ^ px)), acc, 0, 0, 0);
        unsigned char* up = ub + OFF_U + (ib * 4 + dvb) * 2048 + lane * 32;
        *(bf16x8*)up = pack8(acc, 0); *(bf16x8*)(up + 16) = pack8(acc, 8);
    }
    {
        const int dkb = wave >> 1, ib = wave & 1;
        const GLAS unsigned short* Ar = KBGt + (32 * dkb + r32) * VTP; const int px = (2 * dkb + (r32 >> 4)) & 7; const GLAS unsigned short* Br = Tb + (32 * ib + r32) * TP + 8 * hi;
        f32x16 acc = f32x16{};
#pragma unroll
        for (int s = 0; s < 4; ++s) acc = __builtin_amdgcn_mfma_f32_32x32x16_bf16(*(const GLAS bf16x8*)(Ar + 8 * ((2 * s + hi) ^ px)), *(const GLAS bf16x8*)(Br + 16 * s), acc, 0, 0, 0);
#pragma unroll
        for (int r = 0; r < 16; ++r) acc[r] = -acc[r];
        const int fb = (ib * 4 + dkb) * 2;
        *(bf16x8*)(ub + OFF_W + fb * 1024 + lane * 16) = pack8(acc, 0); *(bf16x8*)(ub + OFF_W + (fb + 1) * 1024 + lane * 16) = pack8(acc, 8);
    }
    __syncthreads();
}

constexpr int OBUF_OFF = 2 * DMA_BYTES, OBP = 136, OBUF_BYTES = 64 * OBP * 2, SCAN_LDS = OBUF_OFF + 2 * OBUF_BYTES;
template <int MODE>
__device__ __forceinline__ void scan_bh(int bh, const unsigned char* ops, const unsigned short* GG, unsigned short* CAT, char* shm, int tid_in) {
    int tid_ = tid_in; asm volatile("" : "+v"(tid_));
    const int tid = tid_, lane = tid & 63, wave = __builtin_amdgcn_readfirstlane(tid >> 6), r32 = lane & 31, hi = lane >> 5;
    const int b = bh >> 2, h = bh & 3;
    const unsigned lds0 = (unsigned)(uintptr_t)shm;
    const unsigned char* ub0 = ops + (size_t)(bh * 128) * UNIT_BYTES;
#define GDN_DMA(n, bufi) do { const unsigned char* src_ = ub0 + (size_t)(n) * UNIT_BYTES + wave * 1024 + lane * 16; const unsigned dst_ = lds0 + (bufi) * DMA_BYTES + wave * 1024; \
        _Pragma("unroll") for (int x_ = 0; x_ < 7; ++x_) glds16(src_ + x_ * 8192, (unsigned)__builtin_amdgcn_readfirstlane(dst_ + x_ * 8192)); } while (0)
#define GDN_DMA14(n, bufi) do { const unsigned char* src_ = ub0 + (size_t)(n) * UNIT_BYTES + (wave & 3) * 1024 + lane * 16; const unsigned dst_ = lds0 + (bufi) * DMA_BYTES + (wave & 3) * 1024; \
        _Pragma("unroll") for (int x_ = 0; x_ < 14; ++x_) glds16(src_ + x_ * 4096, (unsigned)__builtin_amdgcn_readfirstlane(dst_ + x_ * 4096)); } while (0)
    const int ptk = 16 * (wave & 3) + (lane >> 2), pcol = 32 * (lane & 3);
    const unsigned short* gg0 = GG + ((size_t)b * 8192) * 512 + h * 128; unsigned short* cat0 = CAT + ((size_t)b * 8192) * 1024 + h * 128;
    GDN_DMA(0, 0);
    asm volatile("s_waitcnt vmcnt(0)" ::: "memory");
    if (wave < 4) {
      u32x4 UA[2][2], UB[2][2]; float GA, GB;
      f32x16 St[4];
#pragma unroll
      for (int d = 0; d < 4; ++d) St[d] = f32x16{};
#define GDN_GLD16(dst, ptr) asm volatile("global_load_dwordx4 %0, %1, off" : "=v"(dst) : "v"(ptr))
#define GDN_GLD4(dst, ptr) asm volatile("global_load_dword %0, %1, off" : "=v"(dst) : "v"(ptr))
#define GDN_ULOAD(U, G, unit) do { const unsigned char* ubn_ = ub0 + (size_t)(unit) * UNIT_BYTES; \
        _Pragma("unroll") for (int ib = 0; ib < 2; ++ib) { const unsigned char* up_ = ubn_ + OFF_U + (ib * 4 + wave) * 2048 + lane * 32; GDN_GLD16(U[ib][0], up_); GDN_GLD16(U[ib][1], up_ + 16); } \
        { const unsigned char* gp_ = ubn_ + OFF_SC; GDN_GLD4(G, gp_); } } while (0)
#define GDN_UWAIT(N, U, G) asm volatile("s_waitcnt vmcnt(" #N ")" : "+v"(U[0][0]), "+v"(U[0][1]), "+v"(U[1][0]), "+v"(U[1][1]), "+v"(G))
#define GDN_UNPACK(U) do { _Pragma("unroll") for (int ib = 0; ib < 2; ++ib) { _Pragma("unroll") for (int r = 0; r < 16; ++r) { const unsigned w = U[ib][r >> 3][(r & 7) >> 1]; vacc[ib][r] = __builtin_bit_cast(float, (r & 1) ? (w & 0xffff0000u) : (w << 16)); } } } while (0)
      GDN_ULOAD(UA, GA, 0); GDN_ULOAD(UB, GB, 1);
      auto cstep = [&](const int n, u32x4 (&U)[2][2], float& G) __attribute__((always_inline)) {
        if (!(MODE & 8)) {
            f32x16 vacc[2], oacc[2]; float glc;
            oacc[0] = f32x16{}; oacc[1] = f32x16{};
            GDN_UWAIT(5, U, G);
            GDN_UNPACK(U); glc = G; asm volatile("" : "+v"(vacc[0]), "+v"(vacc[1]), "+v"(glc));
            GDN_ULOAD(U, G, n + 2 < 128 ? n + 2 : 127);
            constexpr int SCAN_PF = 6;
            bf16x8 fr[SCAN_PF];
#define GDN_FOFF(i) ((i) < 32 ? (((i) & 1) ? OFF_Q : OFF_W) + ((i) >> 1) * 1024 \
                   : (i) < 48 ? OFF_KT + (((((i) - 32) & 3) * 2 + ((((i) - 32) >> 2) >> 1)) * 2 + ((((i) - 32) >> 2) & 1)) * 1024 \
                   : OFF_P + ((((i) - 48) % 3 == 0 ? 0 : ((i) - 48) % 3 == 1 ? 2 : 3) * 2 + ((i) - 48) / 3) * 1024)
            const unsigned bufa = (unsigned)(uintptr_t)(shm) + (n & 1) * DMA_BYTES + lane * 16;
#define GDN_LDFR(dst, i) asm volatile("ds_read_b128 %0, %1 offset:%2" : "=v"(dst) : "v"(bufa), "i"(GDN_FOFF(i)))
#pragma unroll
            for (int j = 0; j < SCAN_PF; ++j) { if (!(MODE & 16)) GDN_LDFR(fr[j], j); else fr[j] = bf16x8{}; }
            bf16x8 Sb[4][2];
#pragma unroll
            for (int d = 0; d < 4; ++d) { Sb[d][0] = pack8(St[d], 0); Sb[d][1] = pack8(St[d], 8); }
            bf16x8 vb[2][2];
            __builtin_amdgcn_sched_barrier(0);
#pragma clang loop unroll(full)
            for (int i = 0; i < 54; ++i) {
                asm volatile("s_waitcnt lgkmcnt(%1)" : "+v"(fr[i % SCAN_PF]) : "i"(53 - i < SCAN_PF - 1 ? 53 - i : SCAN_PF - 1));
                const bf16x8 af = fr[i % SCAN_PF];
                if (i < 32) { const int f = i >> 1, ib = f >> 3, d = (f >> 1) & 3, sx = f & 1;
                    if (i & 1) oacc[ib] = __builtin_amdgcn_mfma_f32_32x32x16_bf16(af, Sb[d][sx], oacc[ib], 0, 0, 0); else vacc[ib] = __builtin_amdgcn_mfma_f32_32x32x16_bf16(af, Sb[d][sx], vacc[ib], 0, 0, 0);
                    St[i >> 3][(i & 7) * 2] *= glc; St[i >> 3][(i & 7) * 2 + 1] *= glc;
                } else if (i < 48) {
                    if (i == 32) {
#pragma unroll
                        for (int ib = 0; ib < 2; ++ib) { vb[ib][0] = pack8(vacc[ib], 0); vb[ib][1] = pack8(vacc[ib], 8); } }
                    const int k = i - 32, d = k & 3, jb = (k >> 2) >> 1, sx = (k >> 2) & 1;
                    St[d] = __builtin_amdgcn_mfma_f32_32x32x16_bf16(af, vb[jb][sx], St[d], 0, 0, 0);
                } else { const int k = i - 48, w = k % 3, sx = k / 3;
                    if (w == 0) oacc[0] = __builtin_amdgcn_mfma_f32_32x32x16_bf16(af, vb[0][sx], oacc[0], 0, 0, 0);
                    else if (w == 1) oacc[1] = __builtin_amdgcn_mfma_f32_32x32x16_bf16(af, vb[0][sx], oacc[1], 0, 0, 0);
                    else oacc[1] = __builtin_amdgcn_mfma_f32_32x32x16_bf16(af, vb[1][sx], oacc[1], 0, 0, 0); }
                if (i + SCAN_PF < 54 && !(MODE & 16)) GDN_LDFR(fr[i % SCAN_PF], i + SCAN_PF);
                __builtin_amdgcn_sched_barrier(0);
            }
#undef GDN_LDFR
#undef GDN_FOFF
            GLAS unsigned short* ob = (GLAS unsigned short*)(shm + OBUF_OFF + (n & 1) * OBUF_BYTES) + 32 * wave + r32;
#pragma unroll
            for (int ib = 0; ib < 2; ++ib)
#pragma unroll
                for (int r = 0; r < 16; ++r) ob[(32 * ib + crow(r, hi)) * OBP] = (unsigned short)(cvtpk(oacc[ib][r], 0.f) & 0xffffu);
        }
      };
#define GDN_SCAN_BAR() asm volatile("s_waitcnt lgkmcnt(0)\n\ts_barrier" ::: "memory")
      for (int n = 0; n <= 128; n += 2) {
        GDN_SCAN_BAR(); if (n == 128) break;
        cstep(n, UA, GA);
        GDN_SCAN_BAR();
        cstep(n + 1, UB, GB);
      }
#undef GDN_SCAN_BAR
    } else {
      u32x4 gA[4], gB[4];
      u32x4 R0[14], R1[14];
      const unsigned char* rsrc = ub0 + (wave & 3) * 1024 + lane * 16;
#pragma unroll
      for (int x = 0; x < 14; ++x) { R0[x] = u32x4{}; R1[x] = u32x4{}; }
#pragma unroll
      for (int x = 0; x < 4; ++x) { gA[x] = u32x4{}; gB[x] = u32x4{}; }
#define GDN_GLD16(dst, ptr) asm volatile("global_load_dwordx4 %0, %1, off" : "=v"(dst) : "v"(ptr))
#define GDN_RLOAD(R, unit) do { const unsigned char* rp_ = rsrc + (size_t)(unit) * UNIT_BYTES; _Pragma("unroll") for (int x = 0; x < 14; ++x) GDN_GLD16(R[x], rp_ + x * 4096); } while (0)
#define GDN_RWAIT(N, R) asm volatile("s_waitcnt vmcnt(" #N ")" : "+v"(R[0]), "+v"(R[1]), "+v"(R[2]), "+v"(R[3]), "+v"(R[4]), "+v"(R[5]), "+v"(R[6]), "+v"(R[7]), "+v"(R[8]), "+v"(R[9]), "+v"(R[10]), "+v"(R[11]), "+v"(R[12]), "+v"(R[13]))
#define GDN_GWAIT(N, G) asm volatile("s_waitcnt vmcnt(" #N ")" : "+v"(G[0]), "+v"(G[1]), "+v"(G[2]), "+v"(G[3]))
      GDN_RLOAD(R1, 1); GDN_RLOAD(R0, 2);
#define GDN_POST_STEP(n, RW, GL, GU) do { \
        asm volatile("s_waitcnt lgkmcnt(0)\n\ts_barrier" ::: "memory");       \
        const bool steady_ = MODE == 0 && (n) >= 3;                         \
        {                                                                      \
            GLAS char* rdst_ = (GLAS char*)(shm) + (((n) + 1) & 1) * DMA_BYTES + (wave & 3) * 1024 + lane * 16; \
            if (!steady_) asm volatile("s_waitcnt vmcnt(0)" ::: "memory");        \
            GDN_RWAIT(30, RW);                                                  \
            if ((n) + 1 < 128) { _Pragma("unroll") for (int x = 0; x < 14; ++x) *(GLAS u32x4*)(rdst_ + x * 4096) = RW[x]; } \
            GDN_RLOAD(RW, (n) + 3 < 128 ? (n) + 3 : 127); } \
        { const int gn_ = (n) < 128 ? (n) : 127; const unsigned short* gp_ = gg0 + (size_t)(gn_ * 64) * 512 + ptk * 512 + pcol;        \
            _Pragma("unroll") for (int i = 0; i < 4; ++i) GDN_GLD16(GL[i], gp_ + 8 * i); } \
        if ((n) > 0 && !(MODE & 2)) { \
            if (!steady_) asm volatile("s_waitcnt vmcnt(0)" ::: "memory"); \
            GDN_GWAIT(22, GU);                                                  \
            const GLAS unsigned short* ob = (const GLAS unsigned short*)(shm + OBUF_OFF + (((n) - 1) & 1) * OBUF_BYTES) + ptk * OBP + pcol; \
            u32x4 xr[4]; \
            _Pragma("unroll") for (int i = 0; i < 4; ++i) xr[i] = *(const GLAS u32x4*)(ob + 8 * i); \
            float x[32]; float ss = 0.f; \
            _Pragma("unroll") for (int i = 0; i < 32; ++i) { const unsigned w = xr[i >> 3][(i & 7) >> 1]; x[i] = __builtin_bit_cast(float, (i & 1) ? (w & 0xffff0000u) : (w << 16)); ss += x[i] * x[i]; } \
            ss += __builtin_bit_cast(float, __builtin_amdgcn_ds_bpermute((lane ^ 1) << 2, __builtin_bit_cast(int, ss))); \
            ss += __builtin_bit_cast(float, __builtin_amdgcn_ds_bpermute((lane ^ 2) << 2, __builtin_bit_cast(int, ss))); \
            const float rs = rsqrtf(ss * (1.f / 128.f) + 1e-6f); \
            unsigned short* op = cat0 + (size_t)(((n) - 1) * 64) * 1024 + ptk * 1024 + pcol; \
            _Pragma("unroll") for (int i4 = 0; i4 < 4; ++i4) { u32x4 o; \
                _Pragma("unroll") for (int e = 0; e < 4; ++e) { const unsigned g = GU[i4][e]; \
                    o[e] = cvtpk(x[8 * i4 + 2 * e] * rs * __builtin_bit_cast(float, g << 16), x[8 * i4 + 2 * e + 1] * rs * __builtin_bit_cast(float, g & 0xffff0000u)); } \
                if (!(MODE & 1)) *(u32x4*)(op + 8 * i4) = o; else asm volatile("" :: "v"(o)); } } \
        } while (0)
      for (int n = 0; n <= 128; n += 2) {
        GDN_POST_STEP(n, R1, gA, gB);
        if (n == 128) break;
        GDN_POST_STEP(n + 1, R0, gB, gA);
      }
#undef GDN_POST_STEP
#undef GDN_GWAIT
#undef GDN_RWAIT
#undef GDN_RLOAD
#undef GDN_GLD16
    }
    asm volatile("s_waitcnt vmcnt(0) lgkmcnt(0)\n\ts_barrier" ::: "memory");
#undef GDN_DMA
#undef GDN_DMA14
}
#undef GLAS
}
__device__ __forceinline__ bf16* wsb(const Args& a, size_t off) { return (bf16*)(a.ws + off); }
__device__ __forceinline__ float* wsf(const Args& a, size_t off) { return (float*)(a.ws + off); }

__device__ __forceinline__ void p0_prologue(const Args& a, Frame& F) {
    LAS float* scr = (LAS float*)(F.lds + RING_OFF + F.wave * 16384);
    constexpr int I_IN = 16 * 80, I_Q = 4 * 24, I_KV = 2 * 32, I_O = 16 * 32, I_UP = 16 * 128, I_DN = 64 * 32, PER = I_IN + I_Q + I_KV + I_O + I_UP + I_DN;
    for (int repa_ = 0; repa_ < (PROBE_DUP == 501 ? 2 : 1); ++repa_)
    for (int it = F.gw; it < 2 * PER; it += F.NGW) {
        const int l = it / PER; int r = it % PER;
        if (r < I_IN) { p0_transpose_item(a.w_in + (size_t)l * 1024 * IN_W, 1024, IN_W, 80, wsb(a, WS_WIN + l * 5 * MiB), nullptr, 0, 0, scr, r, F.lane, MapWin()); continue; } r -= I_IN;
        if (r < I_Q) { p0_transpose_item(a.w_q_up + (size_t)l * 256 * 768, 256, 768, 24, wsb(a, WS_WQ + l * 384 * KiB), a.q_norm + l * 256, 256, 255, scr, r, F.lane, MapId()); continue; } r -= I_Q;
        if (r < I_KV) { p0_transpose_item(a.w_kv_up + (size_t)l * 128 * 1024, 128, 1024, 32, wsb(a, WS_WKV + l * 256 * KiB), a.kv_norm + l * 128, 128, 127, scr, r, F.lane, MapId()); continue; } r -= I_KV;
        if (r < I_O) { p0_transpose_item(a.w_out + (size_t)l * 1024 * 1024, 1024, 1024, 32, wsb(a, WS_WOUT + l * 2 * MiB), a.gdn_norm + l * 128, 512, 127, scr, r, F.lane, MapId()); continue; } r -= I_O;
        if (r < I_UP) { p0_transpose_item(a.w_up + (size_t)l * 1024 * FF, 1024, FF, 128, wsb(a, WS_WUP + l * 8 * MiB), nullptr, 0, 0, scr, r, F.lane, MapId()); continue; } r -= I_UP;
        p0_transpose_item(a.w_down + (size_t)l * FF * 1024, FF, 1024, 32, wsb(a, WS_WDN + l * 8 * MiB), nullptr, 0, 0, scr, r, F.lane, MapId());
    }
    float* ct = wsf(a, WS_COS); float* sn = wsf(a, WS_SIN);
    for (int i = F.gw * 64 + F.lane; i < M * 16; i += F.NGW * 64) {
        const int m = i >> 4, j = i & 15;
        const float inv = __builtin_amdgcn_exp2f(-(float)j * 0.8304820237218406f);
        const float ang = (float)a.pos[m] * inv;
        ct[i] = cosf(ang); sn[i] = sinf(ang);
    }
    for (int repb_ = 0; repb_ < (PROBE_DUP == 502 ? 2 : 1); ++repb_)
    for (int m = F.gw; m < M; m += 4 * F.NGW) rms_rows_to_bf16<4>(F.lane, a.x + (size_t)m * D, (size_t)F.NGW * D, a.mix_pre, wsb(a, WS_XN) + (size_t)m * D);
}

constexpr float QSCALE = 0.10206207261596577f * 1.4426950408889634f;
__device__ __forceinline__ void mla_side(const Args& a, Frame& F, int l) {
    const bf16* REST = wsb(a, WS_REST);
    float* beta = wsf(a, WS_BETA); float* loga = wsf(a, WS_LOGA);
    for (int i = F.gw * 64 + F.lane; i < M * 4; i += F.NGW * 64) {
        const int m = i >> 2, h = i & 3;
        const float bl = bf2f(REST[(size_t)m * 512 + R_GB + h]), al = bf2f(REST[(size_t)m * 512 + R_GA + h]) + a.dt_bias[l * 4 + h];
        beta[i] = 1.f / (1.f + __expf(-bl));
        const float sp = fmaxf(al, 0.f) + __logf(1.f + __expf(-fabsf(al)));
        loga[i] = -__expf(a.a_log[l * 4 + h]) * sp;
    }
    bf16* K = wsb(a, WS_K); const float* ct = wsf(a, WS_COS); const float* sn = wsf(a, WS_SIN);
    for (int m4 = F.gw * 4; m4 < M; m4 += F.NGW * 4) {
        const int m = m4 + (F.lane >> 4), h = F.lane & 7, hf = (F.lane >> 3) & 1;
        const bf16* kr = REST + (size_t)m * 512 + R_KR;
        const v4u k0 = *(const v4u*)kr, k1 = *(const v4u*)(kr + 8), k2 = *(const v4u*)(kr + 16), k3 = *(const v4u*)(kr + 24);
        const f32x4* cp = (const f32x4*)(ct + (size_t)m * 16); const f32x4* sp = (const f32x4*)(sn + (size_t)m * 16);
        float o[16];
#pragma unroll
        for (int q4 = 0; q4 < 4; ++q4) { const f32x4 c4 = cp[q4], s4 = sp[q4];
#pragma unroll
            for (int e = 0; e < 4; ++e) { const int j = 4 * q4 + e;
                const unsigned w1 = j < 8 ? k0[j >> 1] : k1[(j - 8) >> 1], w2 = j < 8 ? k2[j >> 1] : k3[(j - 8) >> 1];
                const float x1 = __builtin_bit_cast(float, (j & 1) ? (w1 & 0xffff0000u) : (w1 << 16)), x2 = __builtin_bit_cast(float, (j & 1) ? (w2 & 0xffff0000u) : (w2 << 16));
                o[j] = hf == 0 ? x1 * c4[e] - x2 * s4[e] : x2 * c4[e] + x1 * s4[e]; } }
        v4u oa, ob;
#pragma unroll
        for (int i = 0; i < 4; ++i) { oa[i] = pk2(o[2 * i], o[2 * i + 1]); ob[i] = pk2(o[8 + 2 * i], o[9 + 2 * i]); }
        bf16* kp = K + (size_t)m * 768 + h * 96 + 64 + 16 * hf;
        *(v4u*)kp = oa; *(v4u*)(kp + 8) = ob;
    }
}
template <int NCOL>
__device__ __forceinline__ void norm_panel(Frame& F, const bf16* REST, int coff, float scale, bf16* dst, int row0) {
    constexpr int LPR = NCOL / 16, RPW = 64 / LPR;
    const int rl = F.lane / LPR, cl = F.lane % LPR;
#pragma unroll
    for (int it = 0; it < 256 / (RPW * NWAVES); ++it) {
        const int m = row0 + (it * NWAVES + F.wave) * RPW + rl;
        const bf16* src = REST + (size_t)m * 512 + coff + 16 * cl;
        const v4u a = *(const v4u*)src, b = *(const v4u*)(src + 8);
        float v[16]; float s = 0.f;
#pragma unroll
        for (int i = 0; i < 16; ++i) { const unsigned w = i < 8 ? a[i >> 1] : b[(i - 8) >> 1]; v[i] = __builtin_bit_cast(float, (i & 1) ? (w & 0xffff0000u) : (w << 16)); s += v[i] * v[i]; }
#pragma unroll
        for (int o = 1; o < LPR; o <<= 1) s += pg8::shx(s, F.lane, o);
        const float rs = rsqrtf(s * (1.f / NCOL) + EPS) * scale;
        v4u oa, ob;
#pragma unroll
        for (int i = 0; i < 4; ++i) { oa[i] = pk2(v[2 * i] * rs, v[2 * i + 1] * rs); ob[i] = pk2(v[8 + 2 * i] * rs, v[9 + 2 * i] * rs); }
        bf16* d = dst + (size_t)m * NCOL + 16 * cl;
        *(v4u*)d = oa; *(v4u*)(d + 8) = ob;
    }
}
__device__ __forceinline__ void gdn_prep_phase(const Args& a, Frame& F, int l, char* lds) {
    const int bh = F.vcu & 7, n0 = F.vcu >> 3, nstep = F.G >> 3;
    { const float* cw = a.conv_w + (size_t)l * 4 * 1536; LAS float* cwl = (LAS float*)(lds + gdn::L_CW); const int h = bh & 3;
      for (int i = F.tid; i < 1536; i += NWAVES * 64) { const int j = i / 384, ar = (i % 384) / 128, c = i % 128; cwl[i] = cw[j * 1536 + ar * 512 + h * 128 + c]; } }
    if (n0 < 128) gdn::prep_issue_raw(bh * 128 + n0, wsb(a, WS_GQ), wsb(a, WS_GK), wsb(a, WS_GV), lds, F.tid);
    for (int n = n0; n < 128; n += nstep)
        gdn::prep_unit(bh * 128 + n, wsb(a, WS_GQ), wsb(a, WS_GK), wsb(a, WS_GV), wsf(a, WS_BETA), wsf(a, WS_LOGA), a.conv_w + (size_t)l * 4 * 1536, a.ws + WS_OPS, lds, F.tid, n + nstep < 128 ? bh * 128 + n + nstep : -1);
}
constexpr int CW_QUEUE = 8192;
#ifndef PROBE_DUP
#define PROBE_DUP -1
#endif
__device__ __forceinline__ void p3_phase(const Args& a, Frame& F, int l, char* lds, volatile LAS unsigned* MISC, int rep = 0, bool do_scan = true, bool do_attn = true) {
    constexpr int SCAN_MODE = (PROBE_DUP >= 60 && PROBE_DUP < 76) ? (PROBE_DUP - 60) : (PROBE_DUP >= 600 && PROBE_DUP < 664) ? (PROBE_DUP - 600) : 0;
    const int per = F.G >> 3, grp = F.vcu / per;
    if (do_scan && F.vcu % per == 0) { if (rep == 0) gdn::scan_bh<0>(grp, a.ws + WS_OPS, wsb(a, WS_GG), wsb(a, WS_CAT), lds, F.tid); else gdn::scan_bh<SCAN_MODE | 1>(grp, a.ws + WS_OPS, wsb(a, WS_GG), wsb(a, WS_CAT), lds, F.tid); }
    if (do_scan && F.vcu % per == 0 && rep == 0) return;
    if (0) gdn::scan_bh<0>(grp, a.ws + WS_OPS, wsb(a, WS_GG), wsb(a, WS_CAT), lds, F.tid);
    if (rep && (PROBE_DUP == 80 || PROBE_DUP == 81)) {
        gu32* flag = (gu32*)(a.ws + WS_CTL) + CW_QUEUE + (l + 2 * rep) * 8 * 64 + 63;
        if (F.vcu % per == 0) { __syncthreads(); if (F.wave * 64 + lane_now() == 0) __hip_atomic_fetch_add(flag, 1u, RLX_AGENT); return; }
        if (PROBE_DUP == 80) {
            typedef __attribute__((ext_vector_type(16))) float f16v; typedef __attribute__((ext_vector_type(8))) short b8v;
            f16v c0 = {}, c1 = {}; b8v av = {1, 2, 3, 4, 5, 6, 7, 8}; asm volatile("" : "+v"(av));
            while (__hip_atomic_load(flag, RLX_AGENT) < 8u) { for (int it = 0; it < 200; ++it) { c0 = __builtin_amdgcn_mfma_f32_32x32x16_bf16(av, av, c0, 0, 0, 0); c1 = __builtin_amdgcn_mfma_f32_32x32x16_bf16(av, av, c1, 0, 0, 0); } }
            asm volatile("" :: "v"(c0), "v"(c1));
        } else {
            const unsigned char* src = (const unsigned char*)wsb(a, WS_K) + (size_t)(F.vcu & 31) * (1u << 20) + (F.wave * 64 + lane_now()) * 16; const unsigned dst = (unsigned)(uintptr_t)lds + F.wave * 1024;
            int it = 0;
            while (__hip_atomic_load(flag, RLX_AGENT) < 8u) { for (int k = 0; k < 8; ++k, ++it) { gdn::glds16(src + (size_t)(it & 63) * 8192, (unsigned)__builtin_amdgcn_readfirstlane(dst)); gdn::glds16(src + (size_t)(it & 63) * 8192 + 524288, (unsigned)__builtin_amdgcn_readfirstlane(dst + 8192)); asm volatile("s_waitcnt vmcnt(6)" ::: "memory"); } }
            asm volatile("s_waitcnt vmcnt(0)" ::: "memory");
        }
        return; }
    if (!do_attn) return;
    gu32* qbase = (gu32*)(a.ws + WS_CTL) + CW_QUEUE + (l + 2 * rep) * 8 * 64;
    for (int gi = 0; gi < 8; ++gi) {
        const int g = (grp + gi) & 7;
        for (;;) {
            const int tnow = F.wave * 64 + lane_now();
            if (tnow == 0) MISC[12] = __hip_atomic_fetch_add(qbase + g * 64, 1u, RLX_AGENT);
            __syncthreads();
            const unsigned idx = MISC[12];
            __syncthreads();
            if (idx >= 64u) break;
            const int bh = 2 * g + (int)(idx & 1u), qb = 31 - (int)(idx >> 1);
            constexpr int ATT_MODE = (PROBE_DUP >= 300 && PROBE_DUP < 428) ? (PROBE_DUP - 300) : 0;
            if (rep) att::attn_unit<ATT_MODE | 1>(bh >> 3, bh & 7, qb, wsb(a, WS_Q), wsb(a, WS_K), wsb(a, WS_V), wsb(a, WS_CAT), wsf(a, WS_COS), wsf(a, WS_SIN), lds, tnow); else
            att::attn_unit<0>(bh >> 3, bh & 7, qb, wsb(a, WS_Q), wsb(a, WS_K), wsb(a, WS_V), wsb(a, WS_CAT), wsf(a, WS_COS), wsf(a, WS_SIN), lds, tnow);
        }
    }
}
__device__ __forceinline__ void gdn_post_naive(const Args& a, Frame& F, int l) {
    const bf16* ORAW = wsb(a, WS_ORAW); const bf16* GG = wsb(a, WS_GG); bf16* CAT = wsb(a, WS_CAT);
    const float* on = a.gdn_norm + l * 128;
    for (int u = F.gw; u < M * 4; u += F.NGW) {
        const int m = u >> 2, h = u & 3;
        const size_t o = (size_t)m * 512 + h * 128 + F.lane;
        const float x0 = bf2f(ORAW[o]), x1 = bf2f(ORAW[o + 64]);
        const float r = rsqrtf(wave_sum(x0 * x0 + x1 * x1, F.lane) * (1.f / 128.f) + EPS);
        CAT[(size_t)m * 1024 + h * 128 + F.lane] = (bf16)f2bf(x0 * r * on[F.lane] * silu_f(bf2f(GG[o])));
        CAT[(size_t)m * 1024 + h * 128 + F.lane + 64] = (bf16)f2bf(x1 * r * on[F.lane + 64] * silu_f(bf2f(GG[o + 64])));
    }
}

#define VGPR_FENCE() asm volatile("" ::: "v0", "v1", "v2", "v3", "v4", "v5", "v6", "v7", "v8", "v9", "v10", "v11", "v12", "v13", "v14", "v15", "v16", "v17", "v18", "v19", "v20", "v21", "v22", "v23", "v24", "v25", "v26", "v27", "v28", "v29", "v30", "v31", "v32", "v33", "v34", "v35", "v36", "v37", "v38", "v39", "v40", "v41", "v42", "v43", "v44", "v45", "v46", "v47", "v48", "v49", "v50", "v51", "v52", "v53", "v54", "v55", "v56", "v57", "v58", "v59", "v60", "v61", "v62", "v63", "v64", "v65", "v66", "v67", "v68", "v69", "v70", "v71", "v72", "v73", "v74", "v75", "v76", "v77", "v78", "v79", "v80", "v81", "v82", "v83", "v84", "v85", "v86", "v87", "v88", "v89", "v90", "v91", "v92", "v93", "v94", "v95", "v96", "v97", "v98", "v99", "v100", "v101", "v102", "v103", "v104", "v105", "v106", "v107", "v108", "v109", "v110", "v111", "v112", "v113", "v114", "v115", "v116", "v117", "v118", "v119", "v120", "v121", "v122", "v123", "v124", "v125", "v126", "v127", "v128", "v129", "v130", "v131", "v132", "v133", "v134", "v135", "v136", "v137", "v138", "v139", "v140", "v141", "v142", "v143", "v144", "v145", "v146", "v147", "v148", "v149", "v150", "v151", "v152", "v153", "v154", "v155", "v156", "v157", "v158", "v159", "v160", "v161", "v162", "v163", "v164", "v165", "v166", "v167", "v168", "v169", "v170", "v171", "v172", "v173", "v174", "v175", "v176", "v177", "v178", "v179", "v180", "v181", "v182", "v183", "v184", "v185", "v186", "v187", "v188", "v189", "v190", "v191", "v192", "v193", "v194", "v195", "v196", "v197", "v198", "v199", "v200", "v201", "v202", "v203", "v204", "v205", "v206", "v207", "v208", "v209", "v210", "v211", "v212", "v213", "v214", "v215", "v216", "v217", "v218", "v219", "v220", "v221", "v222", "v223", "v224", "v225", "v226", "v227", "v228", "v229", "v230", "v231", "v232", "v233", "v234", "v235", "v236", "v237", "v238", "v239", "v240", "v241", "v242", "v243")
__device__ __forceinline__ void frame_init(Frame& F, LAS unsigned char* ldsb) {
    F.lds = ldsb; F.lane = lane_now(); F.tid = F.wave * 64 + F.lane;
    int G = gridDim.x, bx = blockIdx.x; asm volatile("" : "+s"(G), "+s"(bx));
    F.G = G; F.vcu = (G % 8 == 0) ? (bx % 8) * (G / 8) + bx / 8 : bx; F.gw = F.vcu * NWAVES + F.wave; F.NGW = G * NWAVES;
}
__device__ __forceinline__ void launder_args(Args& a, Frame& F) { asm volatile("" : "+s"(a.ws), "+s"(a.out)); asm volatile("" : "+s"(F.wave)); frame_init(F, F.lds); }
constexpr int PH_PER_LAYER = 7, N_PHASES = 1 + 2 * PH_PER_LAYER;
__device__ __forceinline__ Args load_args() {
#if defined(__HIP_DEVICE_COMPILE__)
    const __attribute__((address_space(4))) unsigned long long* p = (const __attribute__((address_space(4))) unsigned long long*)__builtin_amdgcn_kernarg_segment_ptr();
    asm volatile("" : "+s"(p));
    struct Raw { unsigned long long w[sizeof(Args) / 8]; } r;
#pragma unroll
    for (int i = 0; i < (int)(sizeof(Args) / 8); ++i) r.w[i] = p[i];
    return __builtin_bit_cast(Args, r);
#else
    return Args{};
#endif
}
__global__ void __launch_bounds__(NWAVES * 64, 2) fwd_kernel(Args a0_unused) {
    extern __shared__ __attribute__((aligned(16))) unsigned char lds[];
    Frame F; F.wave = __builtin_amdgcn_readfirstlane((int)threadIdx.x >> 6); frame_init(F, (LAS unsigned char*)lds);
    for (int u = F.tid; u < (LDS_BYTES - LDSCTL_OFF) / 4; u += NWAVES * 64) ((LAS unsigned*)(F.lds + LDSCTL_OFF))[u] = 0u;
    __syncthreads();
    volatile LAS unsigned* MISC = (volatile LAS unsigned*)((LAS unsigned char*)lds + MISC_OFF);
    { gu32* ctl = (gu32*)(load_args().ws + WS_CTL); (void)xcd_barrier_post((unsigned*)(ctl + CW_BAR), MISC + 8, F.tid); }
#define IN(k) (true)
#define LAUNDER if (Args a = load_args(); true) if ((launder_args(a, F)), true)
#define SEAM(k) do { if ((k) + 1 < N_PHASES) { unsigned char* wsl_ = load_args().ws; asm volatile("" : "+s"(wsl_)); XcdBarrier bar_; bar_.bar = (unsigned*)(wsl_ + WS_CTL) + CW_BAR; bar_.x = xb_xcc_id(); \
        bar_.st = (volatile LAS unsigned*)((LAS unsigned char*)lds + MISC_OFF) + 8; xcd_barrier(bar_, F.wave * 64 + lane_now()); } } while (0)
    for (int rep_ = 0; rep_ < (PROBE_DUP == 99 ? 2 : 1); ++rep_)
    if (IN(0)) LAUNDER p0_prologue(a, F);
    SEAM(0);
#pragma unroll 1
    for (int l = 0; l < 2; ++l) {
        const int pb = 1 + PH_PER_LAYER * l;
        for (int rep_ = 0; rep_ < (PROBE_DUP == 100 ? 2 : 1); ++rep_)
        if (IN(pb + 0)) LAUNDER {
            pg8::Gemm g{wsb(a, l == 0 ? WS_XN : WS_XN1), wsb(a, WS_WIN + l * 5 * MiB), M, NPROJ, 1024}; pg8::StaticOrder S; S.init(M, NPROJ, F.G, (int)blockIdx.x);
            typedef pg8::EpiPk<1, 0, false> EP; EP E{wsb(a, WS_GQ), wsb(a, WS_GK), wsb(a, WS_GV), wsb(a, WS_GG), wsb(a, WS_REST), 512, nullptr};
            pg8::gemm_phase<EP, pg8::StaticOrder, true>(F.lds + RING_OFF, g, S, E, F.tid);
        }
        SEAM(pb + 0);
        for (int rep2_ = 0; rep2_ < (PROBE_DUP == 101 ? 2 : 1); ++rep2_) {
        for (int r3_ = 0; r3_ < (PROBE_DUP == 111 ? 2 : 1); ++r3_)
        if (IN(pb + 1)) LAUNDER mla_side(a, F, l);
        for (int r4_ = 0; r4_ < (PROBE_DUP == 112 ? 2 : 1); ++r4_)
        if (IN(pb + 1)) LAUNDER {
            pg8::StaticOrder S; S.init(M, 768, F.G, (int)blockIdx.x);
            { pg8::Unit u; for (int i = 0; S.next(i, u); ++i) norm_panel<256>(F, wsb(a, WS_REST), R_CQ, QSCALE, wsb(a, WS_CQN), u.pm * 256); }
            S.init(M, 1024, F.G, (int)blockIdx.x);
            { pg8::Unit u; for (int i = 0; S.next(i, u); ++i) norm_panel<128>(F, wsb(a, WS_REST), R_CKV, 1.f, wsb(a, WS_CKVN), u.pm * 256); }
            VM_WAIT(); __syncthreads();
        }
        for (int r5_ = 0; r5_ < (PROBE_DUP == 113 ? 2 : 1); ++r5_)
        if (IN(pb + 1)) LAUNDER {
            pg8::Gemm g{wsb(a, WS_CQN), wsb(a, WS_WQ + l * 384 * KiB), M, 768, 256}; pg8::StaticOrder S; S.init(M, 768, F.G, (int)blockIdx.x);
            typedef pg8::EpiPk<0, 0, false> EP; EP E{wsb(a, WS_Q), nullptr, nullptr, nullptr, nullptr, 768, nullptr};
            pg8::gemm_phase<EP, pg8::StaticOrder, true>(F.lds + RING_OFF, g, S, E, F.tid);
        }
        for (int r6_ = 0; r6_ < (PROBE_DUP == 115 ? 2 : 1); ++r6_)
        if (IN(pb + 1)) LAUNDER {
            pg8::Gemm g{wsb(a, WS_CKVN), wsb(a, WS_WKV + l * 256 * KiB), M, 1024, 128}; pg8::StaticOrder S; S.init(M, 1024, F.G, (int)blockIdx.x);
            typedef pg8::EpiPk<2, 0, false> EP; EP E{wsb(a, WS_K), wsb(a, WS_V), nullptr, nullptr, nullptr, 0, nullptr};
            pg8::gemm_phase<EP, pg8::StaticOrder, true>(F.lds + RING_OFF, g, S, E, F.tid);
        }
        }
        SEAM(pb + 1);
        for (int rep_ = 0; rep_ < (PROBE_DUP == 102 ? 2 : 1); ++rep_)
        if (IN(pb + 2)) LAUNDER gdn_prep_phase(a, F, l, (char*)lds + RING_OFF);
        SEAM(pb + 2);
        if (IN(pb + 3)) LAUNDER p3_phase(a, F, l, (char*)lds + RING_OFF, (volatile LAS unsigned*)((LAS unsigned char*)lds + MISC_OFF));
        SEAM(pb + 3);
        if (PROBE_DUP == 5 || PROBE_DUP == 50 || PROBE_DUP == 51 || (PROBE_DUP >= 60 && PROBE_DUP < 82) || (PROBE_DUP >= 600 && PROBE_DUP < 664) || (PROBE_DUP >= 300 && PROBE_DUP < 428)) { LAUNDER p3_phase(a, F, l, (char*)lds + RING_OFF, (volatile LAS unsigned*)((LAS unsigned char*)lds + MISC_OFF), 1, PROBE_DUP != 51 && (PROBE_DUP < 300 || PROBE_DUP >= 600), PROBE_DUP == 5 || PROBE_DUP == 51 || (PROBE_DUP >= 300 && PROBE_DUP < 428)); SEAM(pb + 3); }
        if (IN(pb + 4)) LAUNDER {
            pg8::Gemm g{wsb(a, WS_CAT), wsb(a, WS_WOUT + l * 2 * MiB), M, 1024, 1024}; pg8::StaticOrder S; S.init(M, 1024, F.G, (int)blockIdx.x);
            unsigned* ctlw = (unsigned*)(a.ws + WS_CTL);
            pg8::PanelRms st1{wsf(a, WS_XCH) + (size_t)(l * 4 + 0) * 65536, ctlw + CW_SEAM + (l * 4 + 0) * SEAM_BANK, ctlw + CW_TMO, EPS};
            pg8::PanelRms st2{wsf(a, WS_XCH) + (size_t)(l * 4 + 1) * 65536, ctlw + CW_SEAM + (l * 4 + 1) * SEAM_BANK, ctlw + CW_TMO, EPS};
            pg8::EpiRmsResRms E{l == 0 ? (const void*)a.x : (const void*)((const char*)a.out + 32 * MiB), l == 0 ? (void*)a.out : (void*)(a.ws + WS_R3), wsb(a, WS_XN), a.mix_post + l * D, a.ffn_pre + l * D, st1, st2, l, 1};
            pg8::gemm_phase<pg8::EpiRmsResRms, pg8::StaticOrder, false>(F.lds + RING_OFF, g, S, E, F.tid);
        }
        if (PROBE_DUP == 104) { SEAM(pb + 3); LAUNDER {
            pg8::Gemm g{wsb(a, WS_CAT), wsb(a, WS_WOUT + l * 2 * MiB), M, 1024, 1024}; pg8::StaticOrder S; S.init(M, 1024, F.G, (int)blockIdx.x);
            unsigned* ctlw = (unsigned*)(a.ws + WS_CTL);
            pg8::PanelRms st1{wsf(a, WS_XCH) + (size_t)(l * 4 + 0) * 65536, ctlw + CW_SEAM + (8 + l * 4 + 0) * SEAM_BANK, ctlw + CW_TMO, EPS};
            pg8::PanelRms st2{wsf(a, WS_XCH) + (size_t)(l * 4 + 1) * 65536, ctlw + CW_SEAM + (8 + l * 4 + 1) * SEAM_BANK, ctlw + CW_TMO, EPS};
            pg8::EpiRmsResRms E{a.x, wsf(a, WS_Q), wsb(a, WS_OPSX), a.mix_post + l * D, a.ffn_pre + l * D, st1, st2, 0, 0};
            pg8::gemm_phase<pg8::EpiRmsResRms, pg8::StaticOrder, false>(F.lds + RING_OFF, g, S, E, F.tid); } }
        if (PROBE_DUP == 114) { SEAM(pb + 3); LAUNDER {
            pg8::Gemm g{wsb(a, WS_CAT), wsb(a, WS_WOUT + l * 2 * MiB), M, 1024, 1024}; pg8::StaticOrder S; S.init(M, 1024, F.G, (int)blockIdx.x);
            pg8::EpiF32 E{wsf(a, WS_Q), 1024};
            pg8::gemm_phase<pg8::EpiF32, pg8::StaticOrder, false>(F.lds + RING_OFF, g, S, E, F.tid); } }
        SEAM(pb + 4);
        for (int rep_ = 0; rep_ < (PROBE_DUP == 105 ? 2 : 1); ++rep_)
        if (IN(pb + 5)) LAUNDER {
            pg8::Gemm g{wsb(a, WS_XN), wsb(a, WS_WUP + l * 8 * MiB), M, FF, 1024}; pg8::StaticOrder S; S.init(M, FF, F.G, (int)blockIdx.x);
            typedef pg8::EpiPk<0, 2, false> EP; EP E{wsb(a, WS_H), nullptr, nullptr, nullptr, nullptr, FF, nullptr};
            pg8::gemm_phase<EP, pg8::StaticOrder, true>(F.lds + RING_OFF, g, S, E, F.tid);
        }
        SEAM(pb + 5);
        if (PROBE_DUP == 400) { SEAM(pb + 5); SEAM(pb + 5); SEAM(pb + 5); SEAM(pb + 5); }
        if (IN(pb + 6)) LAUNDER {
            pg8::Gemm g{wsb(a, WS_H), wsb(a, WS_WDN + l * 8 * MiB), M, 1024, FF}; pg8::StaticOrder S; S.init(M, 1024, F.G, (int)blockIdx.x);
            unsigned* ctlw = (unsigned*)(a.ws + WS_CTL);
            pg8::PanelRms st1{wsf(a, WS_XCH) + (size_t)(l * 4 + 2) * 65536, ctlw + CW_SEAM + (l * 4 + 2) * SEAM_BANK, ctlw + CW_TMO, EPS};
            pg8::PanelRms st2{wsf(a, WS_XCH) + (size_t)(l * 4 + 3) * 65536, ctlw + CW_SEAM + (l * 4 + 3) * SEAM_BANK, ctlw + CW_TMO, EPS};
            pg8::EpiRmsResRms E{l == 0 ? (const void*)a.out : (const void*)(a.ws + WS_R3), l == 0 ? (void*)((char*)a.out + 32 * MiB) : (void*)a.out, l == 0 ? wsb(a, WS_XN1) : nullptr, a.ffn_post + l * D, a.mix_pre + D, st1, st2, 1, l == 0};
            pg8::gemm_phase<pg8::EpiRmsResRms, pg8::StaticOrder, false>(F.lds + RING_OFF, g, S, E, F.tid);
        }
        if (PROBE_DUP == 106) { SEAM(pb + 5); LAUNDER {
            pg8::Gemm g{wsb(a, WS_H), wsb(a, WS_WDN + l * 8 * MiB), M, 1024, FF}; pg8::StaticOrder S; S.init(M, 1024, F.G, (int)blockIdx.x);
            unsigned* ctlw = (unsigned*)(a.ws + WS_CTL);
            pg8::PanelRms st1{wsf(a, WS_XCH) + (size_t)(l * 4 + 2) * 65536, ctlw + CW_SEAM + (8 + l * 4 + 2) * SEAM_BANK, ctlw + CW_TMO, EPS};
            pg8::PanelRms st2{wsf(a, WS_XCH) + (size_t)(l * 4 + 3) * 65536, ctlw + CW_SEAM + (8 + l * 4 + 3) * SEAM_BANK, ctlw + CW_TMO, EPS};
            pg8::EpiRmsResRms E{a.x, wsf(a, WS_XN), nullptr, a.ffn_post + l * D, a.mix_pre + D, st1, st2, 0, 0};
            pg8::gemm_phase<pg8::EpiRmsResRms, pg8::StaticOrder, false>(F.lds + RING_OFF, g, S, E, F.tid); } }
        SEAM(pb + 6);
            }
#undef IN
#undef SEAM
}

#ifndef MK_SPLIT
#define MK_SPLIT 0
#endif
extern "C" void kernel_launch(void* const* d_in, const int* in_sizes, int n_in, void* d_out, int out_size, void* d_ws, size_t ws_size, hipStream_t stream) {
    static int grid = 0;
    if (grid == 0) {
        if (n_in != 18 || in_sizes[0] != M * D || out_size != M * D || ws_size < WS_END) { fprintf(stderr, "kernel_launch: unexpected shapes (n_in %d, in0 %d, out %d, ws %zu)\n", n_in, n_in > 0 ? in_sizes[0] : -1, out_size, ws_size); grid = -1; return; }
        int dev = 0, cus = 0, per_cu = 0;
        if (hipGetDevice(&dev) != hipSuccess || hipDeviceGetAttribute(&cus, hipDeviceAttributeMultiprocessorCount, dev) != hipSuccess) { grid = -1; return; }
        if (hipFuncSetAttribute((const void*)fwd_kernel, hipFuncAttributeMaxDynamicSharedMemorySize, LDS_BYTES) != hipSuccess) { fprintf(stderr, "kernel_launch: hipFuncSetAttribute failed\n"); grid = -1; return; }
        if (hipOccupancyMaxActiveBlocksPerMultiprocessor(&per_cu, (const void*)fwd_kernel, NWAVES * 64, LDS_BYTES) != hipSuccess || per_cu < 1) fprintf(stderr, "kernel_launch: occupancy query reports %d\n", per_cu);
        (void)hipGetLastError();
        grid = cus;
    }
    if (grid < 0) return;
    if (hipMemsetAsync((char*)d_ws + WS_CTL, 0, CTL_ZERO_BYTES, stream) != hipSuccess) { fprintf(stderr, "kernel_launch: memset failed\n"); return; }
    Args a{};
    a.x = (const float*)d_in[0]; a.pos = (const int*)d_in[1]; a.mix_pre = (const float*)d_in[2]; a.w_in = (const float*)d_in[3]; a.conv_w = (const float*)d_in[4];
    a.a_log = (const float*)d_in[5]; a.dt_bias = (const float*)d_in[6]; a.gdn_norm = (const float*)d_in[7]; a.q_norm = (const float*)d_in[8]; a.w_q_up = (const float*)d_in[9];
    a.kv_norm = (const float*)d_in[10]; a.w_kv_up = (const float*)d_in[11]; a.w_out = (const float*)d_in[12]; a.mix_post = (const float*)d_in[13]; a.ffn_pre = (const float*)d_in[14];
    a.w_up = (const float*)d_in[15]; a.w_down = (const float*)d_in[16]; a.ffn_post = (const float*)d_in[17];
    a.out = (float*)d_out; a.ws = (unsigned char*)d_ws;
    a.ph_lo = 0; a.ph_hi = N_PHASES;
    hipLaunchKernelGGL(fwd_kernel, dim3(grid), dim3(NWAVES * 64), LDS_BYTES, stream, a);
    const hipError_t le = hipPeekAtLastError();
    if (le != hipSuccess) fprintf(stderr, "kernel_launch: launch failed: %s\n", hipGetErrorName(le));
}
```
